# Optimizing an MI355X kernel written in HIP

```python
import math
import jax, jax.numpy as jnp
from jax import lax
import numpy as np

D_MODEL = 1024
BATCH = 8
SEQ = 8192
DEPTH = 2

SSM_WIDTH = 512
SSM_GROUP = 16
SSM_GROUPS = SSM_WIDTH // SSM_GROUP
SSM_STATE = 64
DT_MIN = 1e-3
DT_MAX = 1e-1
HEAD_DIM = 128
N_HEADS = D_MODEL // HEAD_DIM
N_KV_HEADS = 2
ATTN_WIDTH = N_HEADS * HEAD_DIM
KV_WIDTH = N_KV_HEADS * HEAD_DIM
IDX_HEADS = 8
IDX_DIM = 64
IDX_SCALE = (IDX_HEADS * IDX_DIM) ** -0.5
TOPK_MAX = 256
Q_BLOCK = 128
ROPE_THETA = 10000.0
D_FF = -(-8 * D_MODEL // (3 * 256)) * 256
DEEPNORM_ALPHA = (2 * DEPTH) ** 0.25
DEEPNORM_BETA = (8 * DEPTH) ** -0.25
LN_EPS = 1e-5
IN_SIZES = (SSM_WIDTH, ATTN_WIDTH, KV_WIDTH, KV_WIDTH, IDX_HEADS * IDX_DIM, IDX_DIM, IDX_HEADS, D_MODEL, D_MODEL)
IN_OFFSETS = [int(o) for o in np.cumsum(IN_SIZES)[:-1]]
D_IN = int(sum(IN_SIZES))

kernel_name = 'hybrid_s5_dsa_deepnorm_block'


def layer_norm(x, g, b):
    xf = x.astype(jnp.float32)
    mu = jnp.mean(xf, axis=-1, keepdims=True)
    var = jnp.mean(jnp.square(xf - mu), axis=-1, keepdims=True)
    y = (xf - mu) * lax.rsqrt(var + LN_EPS) * g.astype(jnp.float32) + b.astype(jnp.float32)
    return y.astype(x.dtype)


def rope(x, pos):
    half = x.shape[-1] // 2
    inv = ROPE_THETA ** (-jnp.arange(half, dtype=jnp.float32) / half)
    ang = pos.astype(jnp.float32)[:, None] * inv[None, :]
    cos = jnp.cos(ang)[:, None, :]
    sin = jnp.sin(ang)[:, None, :]
    xf = x.astype(jnp.float32)
    x1, x2 = xf[..., :half], xf[..., half:]
    out = jnp.concatenate([x1 * cos - x2 * sin, x2 * cos + x1 * sin], axis=-1)
    return out.astype(x.dtype)


def s5_branch(u, lam_re, lam_im, log_dt, b_re, b_im, c_re, c_im, d_skip, w_glu, b_glu):
    bsz, L, _ = u.shape
    f32 = jnp.float32
    uf = u.astype(f32).reshape(bsz, L, SSM_GROUPS, SSM_GROUP)
    dt = jnp.exp(log_dt.astype(f32))[:, None]
    lr, li = lam_re.astype(f32), lam_im.astype(f32)
    mag = jnp.exp(lr * dt)
    ar = mag * jnp.cos(li * dt)
    ai = mag * jnp.sin(li * dt)
    den = lr * lr + li * li
    nr = ar - 1.0
    fr = (nr * lr + ai * li) / den
    fi = (ai * lr - nr * li) / den
    br, bi = b_re.astype(f32), b_im.astype(f32)
    bbr = fr[..., None] * br - fi[..., None] * bi
    bbi = fr[..., None] * bi + fi[..., None] * br
    xr = jnp.einsum('bsgi,gpi->bsgp', uf, bbr)
    xi = jnp.einsum('bsgi,gpi->bsgp', uf, bbi)
    a_r = jnp.broadcast_to(ar, (1, L) + ar.shape)
    a_i = jnp.broadcast_to(ai, (1, L) + ai.shape)

    def combine(e1, e2):
        a1r, a1i, b1r, b1i = e1
        a2r, a2i, b2r, b2i = e2
        return (a1r * a2r - a1i * a2i,
                a1r * a2i + a1i * a2r,
                a2r * b1r - a2i * b1i + b2r,
                a2r * b1i + a2i * b1r + b2i)

    _, _, hr, hi = lax.associative_scan(combine, (a_r, a_i, xr, xi), axis=1)
    y = (jnp.einsum('bsgp,gip->bsgi', hr, c_re.astype(f32))
         - jnp.einsum('bsgp,gip->bsgi', hi, c_im.astype(f32))
         + d_skip.astype(f32).reshape(SSM_GROUPS, SSM_GROUP) * uf)
    y = jax.nn.gelu(y.reshape(bsz, L, SSM_WIDTH))
    y = y * jax.nn.sigmoid(y @ w_glu.astype(f32) + b_glu.astype(f32))
    return y.astype(u.dtype)


def dsa_branch(q, k, v, q_idx, k_idx, w_idx):
    bsz, L = q.shape[0], q.shape[1]
    n_sel = min(TOPK_MAX, L // 4)
    nblk = L // Q_BLOCK
    grp = N_HEADS // N_KV_HEADS
    key_pos = jnp.arange(L)
    bidx = jnp.arange(bsz)[:, None, None]

    def to_blocks(t):
        return jnp.swapaxes(t.reshape((bsz, nblk, Q_BLOCK) + t.shape[2:]), 0, 1)

    def block_fn(args):
        qb, qib, wb, start = args
        q_pos = start + jnp.arange(Q_BLOCK)
        causal = key_pos[None, :] <= q_pos[:, None]
        rel = jax.nn.relu(jnp.einsum('bqhd,bsd->bqhs', qib, k_idx).astype(jnp.float32))
        score = jnp.einsum('bqhs,bqh->bqs', rel, wb.astype(jnp.float32) * IDX_SCALE)
        score = jnp.where(causal[None], score, -jnp.inf)
        _, sel = lax.top_k(score, n_sel)
        valid = sel <= q_pos[None, :, None]
        ks = k[bidx, sel]
        vs = v[bidx, sel]
        qg = qb.reshape(bsz, Q_BLOCK, N_KV_HEADS, grp, HEAD_DIM)
        logits = jnp.einsum('bqhgd,bqnhd->bqhgn', qg, ks).astype(jnp.float32) * (HEAD_DIM ** -0.5)
        logits = jnp.where(valid[:, :, None, None, :], logits, -jnp.inf)
        p = jax.nn.softmax(logits, axis=-1).astype(vs.dtype)
        o = jnp.einsum('bqhgn,bqnhd->bqhgd', p, vs)
        return o.reshape(bsz, Q_BLOCK, ATTN_WIDTH)

    starts = jnp.arange(nblk) * Q_BLOCK
    out = lax.map(block_fn, (to_blocks(q), to_blocks(q_idx), to_blocks(w_idx), starts))
    return jnp.swapaxes(out, 0, 1).reshape(bsz, L, ATTN_WIDTH)


def hybrid_mixer(u, pos, w_in, lam_re, lam_im, log_dt, b_re, b_im, c_re, c_im, d_skip,
                 w_glu, b_glu, p_ssm, p_attn, w_out):
    bsz, L, _ = u.shape
    z = u @ w_in
    u_ssm, q, k, v, q_idx, k_idx, w_idx, g_ssm, g_attn = jnp.split(z, IN_OFFSETS, axis=-1)
    y_ssm = s5_branch(u_ssm, lam_re, lam_im, log_dt, b_re, b_im, c_re, c_im, d_skip, w_glu, b_glu)
    q = rope(q.reshape(bsz, L, N_HEADS, HEAD_DIM), pos)
    k = rope(k.reshape(bsz, L, N_KV_HEADS, HEAD_DIM), pos)
    v = v.reshape(bsz, L, N_KV_HEADS, HEAD_DIM)
    q_idx = rope(q_idx.reshape(bsz, L, IDX_HEADS, IDX_DIM), pos)
    k_idx = rope(k_idx.reshape(bsz, L, 1, IDX_DIM), pos)[:, :, 0]
    y_attn = dsa_branch(q, k, v, q_idx, k_idx, w_idx)
    merged = jax.nn.sigmoid(g_ssm) * (y_ssm @ p_ssm) + jax.nn.sigmoid(g_attn) * (y_attn @ p_attn)
    return merged @ w_out


def swiglu_ffn(u, w_gate_up, w_down):
    a, b = jnp.split(u @ w_gate_up, 2, axis=-1)
    return (jax.nn.silu(a) * b) @ w_down


def setup_inputs(seed: int = 0) -> dict:
    key = jax.random.key(seed)
    ks = jax.random.split(key, 24)
    f32 = jnp.float32

    def nrm(k, shape, std):
        return std * jax.random.normal(k, shape, f32)

    n = jnp.arange(SSM_STATE, dtype=f32)
    return {
        'x': nrm(ks[0], (BATCH, SEQ, D_MODEL), 1.0),
        'c': nrm(ks[1], (BATCH, D_MODEL), 1.0),
        'w_cond': nrm(ks[2], (DEPTH, D_MODEL, 6 * D_MODEL), 0.5 * D_MODEL ** -0.5),
        'b_cond': nrm(ks[3], (DEPTH, 6 * D_MODEL), 0.02),
        'w_in': nrm(ks[4], (DEPTH, D_MODEL, D_IN), D_MODEL ** -0.5),
        'ssm_lam_re': -0.5 + nrm(ks[5], (DEPTH, SSM_GROUPS, SSM_STATE), 0.01),
        'ssm_lam_im': math.pi * n + nrm(ks[6], (DEPTH, SSM_GROUPS, SSM_STATE), 0.01),
        'ssm_log_dt': jax.random.uniform(ks[7], (DEPTH, SSM_GROUPS), f32, math.log(DT_MIN), math.log(DT_MAX)),
        'ssm_b_re': nrm(ks[8], (DEPTH, SSM_GROUPS, SSM_STATE, SSM_GROUP), (2 * SSM_GROUP) ** -0.5),
        'ssm_b_im': nrm(ks[9], (DEPTH, SSM_GROUPS, SSM_STATE, SSM_GROUP), (2 * SSM_GROUP) ** -0.5),
        'ssm_c_re': nrm(ks[10], (DEPTH, SSM_GROUPS, SSM_GROUP, SSM_STATE), SSM_STATE ** -0.5),
        'ssm_c_im': nrm(ks[11], (DEPTH, SSM_GROUPS, SSM_GROUP, SSM_STATE), SSM_STATE ** -0.5),
        'ssm_d': nrm(ks[12], (DEPTH, SSM_WIDTH), 1.0),
        'ssm_w_glu': nrm(ks[13], (DEPTH, SSM_WIDTH, SSM_WIDTH), SSM_WIDTH ** -0.5),
        'ssm_b_glu': nrm(ks[14], (DEPTH, SSM_WIDTH), 0.02),
        'p_ssm': nrm(ks[15], (DEPTH, SSM_WIDTH, D_MODEL), SSM_WIDTH ** -0.5),
        'p_attn': nrm(ks[16], (DEPTH, ATTN_WIDTH, D_MODEL), ATTN_WIDTH ** -0.5),
        'w_out': nrm(ks[17], (DEPTH, D_MODEL, D_MODEL), DEEPNORM_BETA * D_MODEL ** -0.5),
        'ln1_g': 1.0 + nrm(ks[18], (DEPTH, D_MODEL), 0.02),
        'ln1_b': nrm(ks[19], (DEPTH, D_MODEL), 0.02),
        'w_gate_up': nrm(ks[20], (DEPTH, D_MODEL, 2 * D_FF), D_MODEL ** -0.5),
        'w_down': nrm(ks[21], (DEPTH, D_FF, D_MODEL), DEEPNORM_BETA * D_FF ** -0.5),
        'ln2_g': 1.0 + nrm(ks[22], (DEPTH, D_MODEL), 0.02),
        'ln2_b': nrm(ks[23], (DEPTH, D_MODEL), 0.02),
    }


def reference(x, c, w_cond, b_cond, w_in, ssm_lam_re, ssm_lam_im, ssm_log_dt, ssm_b_re, ssm_b_im,
              ssm_c_re, ssm_c_im, ssm_d, ssm_w_glu, ssm_b_glu, p_ssm, p_attn, w_out,
              ln1_g, ln1_b, w_gate_up, w_down, ln2_g, ln2_b):
    L = x.shape[1]
    pos = jnp.arange(L)
    cond_in = jax.nn.silu(c)
    for l in range(DEPTH):
        mod = cond_in @ w_cond[l] + b_cond[l]
        sh1, sc1, gt1, sh2, sc2, gt2 = [m[:, None, :] for m in jnp.split(mod, 6, axis=-1)]
        u = x * (1.0 + sc1) + sh1
        h = hybrid_mixer(u, pos, w_in[l], ssm_lam_re[l], ssm_lam_im[l], ssm_log_dt[l], ssm_b_re[l],
                         ssm_b_im[l], ssm_c_re[l], ssm_c_im[l], ssm_d[l], ssm_w_glu[l], ssm_b_glu[l],
                         p_ssm[l], p_attn[l], w_out[l])
        x = layer_norm(DEEPNORM_ALPHA * x + (1.0 + gt1) * h, ln1_g[l], ln1_b[l])
        u = x * (1.0 + sc2) + sh2
        f = swiglu_ffn(u, w_gate_up[l], w_down[l])
        x = layer_norm(DEEPNORM_ALPHA * x + (1.0 + gt2) * f, ln2_g[l], ln2_b[l])
    return x
```

```cpp
#include <hip/hip_runtime.h>
#include <hip/hip_cooperative_groups.h>
#include <cstdio>
#include <cstdint>
namespace cg = cooperative_groups;

#ifndef DIAG_PSEUDO
#define DIAG_PSEUDO 0
#endif
#ifndef DIAG_SCALE
#define DIAG_SCALE 0
#endif
#ifndef MEGA
#define MEGA 1
#endif

typedef unsigned short bf16_t;
typedef short bf16x8 __attribute__((ext_vector_type(8)));
typedef float f32x4 __attribute__((ext_vector_type(4)));
typedef float f32x16 __attribute__((ext_vector_type(16)));
typedef unsigned u32x4 __attribute__((ext_vector_type(4)));
#define DI __device__ __forceinline__

constexpr int SEQ = 8192, NB = 8, DM = 1024, NTOK = NB * SEQ;
constexpr int DINP = 4736;
constexpr int DFF = 2816;
constexpr float ALPHA = 1.41421356237f;
constexpr float IDX_SCALE = 0.04419417382415922f;
constexpr float ATT_SCALE = 0.08838834764831845f;
constexpr int LDS_BYTES = 77824;

constexpr size_t WO_IN = 0, WO_GLU = WO_IN + (size_t)4864 * 1024, WO_PSSM = WO_GLU + 512 * 512, WO_PATTN = WO_PSSM + 1024 * 512,
                 WO_OUT = WO_PATTN + 1024 * 1024, WO_GU = WO_OUT + 1024 * 1024, WO_DOWN = WO_GU + (size_t)5632 * 1024, WO_LAYER = WO_DOWN + (size_t)1024 * DFF;

struct P {
  const float *x, *c, *w_cond, *b_cond, *w_in, *lam_re, *lam_im, *log_dt, *b_re, *b_im, *c_re, *c_im, *d_skip, *w_glu, *b_glu, *p_ssm, *p_attn, *w_out,
      *ln1_g, *ln1_b, *w_gu, *w_down, *ln2_g, *ln2_b;
  float* out;
  bf16_t* wT;
  float2* rope128;
  float2* rope64;
  float4* ssmA;
  float2* ssmB;
  float* mod;
  float2* E;
  float* XA;
  bf16_t *u_ssm, *q, *k, *v, *qidx, *kidx;
  unsigned char *k8, *v8;
  float* widx;
  bf16_t *sg_s, *sg_a;
  unsigned short* sel;
  unsigned* scr;
  bf16_t *y_pre, *y_ssm, *act, *u2;
};

DI int TIDX() { int t = __builtin_amdgcn_workitem_id_x(); asm volatile("" : "+v"(t)); return t; }
DI float bf2f(bf16_t h) { return __uint_as_float(((unsigned)h) << 16); }
DI bf16_t f2bf(float x) { return __builtin_bit_cast(bf16_t, (__bf16)x); }
typedef __bf16 hwbf16x2 __attribute__((ext_vector_type(2)));
typedef float hwf32x2 __attribute__((ext_vector_type(2)));
DI unsigned pack2(float a, float b) { const hwf32x2 f = {a, b}; return __builtin_bit_cast(unsigned, __builtin_convertvector(f, hwbf16x2)); }
DI float sigm(float x) { return __builtin_amdgcn_rcpf(1.f + __expf(-x)); }
DI uint2 pack8_fp8(const float* v) {
  int w0 = 0, w1 = 0;
  w0 = __builtin_amdgcn_cvt_pk_fp8_f32(v[0], v[1], w0, false); w0 = __builtin_amdgcn_cvt_pk_fp8_f32(v[2], v[3], w0, true);
  w1 = __builtin_amdgcn_cvt_pk_fp8_f32(v[4], v[5], w1, false); w1 = __builtin_amdgcn_cvt_pk_fp8_f32(v[6], v[7], w1, true);
  uint2 r; r.x = (unsigned)w0; r.y = (unsigned)w1; return r;
}
typedef float f32x2_t __attribute__((ext_vector_type(2)));
DI void fp8x4_to_bf16x4(unsigned w, unsigned& lo, unsigned& hi) {
  const f32x2_t a = __builtin_amdgcn_cvt_pk_f32_fp8((int)w, false), b = __builtin_amdgcn_cvt_pk_f32_fp8((int)w, true);
  lo = (__float_as_uint(a.x) >> 16) | (__float_as_uint(a.y) & 0xffff0000u);
  hi = (__float_as_uint(b.x) >> 16) | (__float_as_uint(b.y) & 0xffff0000u);
}
DI uint4 pack8(const float* v) { uint4 r; r.x = pack2(v[0], v[1]); r.y = pack2(v[2], v[3]); r.z = pack2(v[4], v[5]); r.w = pack2(v[6], v[7]); return r; }

struct ALoadBf16 {
  const bf16_t* A; int lda;
  DI u32x4 load(int row, int k) const { return *(const u32x4*)(A + (size_t)row * lda + k); }
};
struct ALoadXMod {
  const float* x; const float* sc; const float* sh;
  DI u32x4 load(int row, int k) const {
    const int b = row >> 13;
    const float4* xp = (const float4*)(x + (size_t)row * 1024 + k);
    const float4* sp = (const float4*)(sc + b * 6144 + k);
    const float4* hp = (const float4*)(sh + b * 6144 + k);
    float4 x0 = xp[0], x1 = xp[1], s0 = sp[0], s1 = sp[1], h0 = hp[0], h1 = hp[1];
    u32x4 r;
    r.x = pack2(x0.x * (1.f + s0.x) + h0.x, x0.y * (1.f + s0.y) + h0.y);
    r.y = pack2(x0.z * (1.f + s0.z) + h0.z, x0.w * (1.f + s0.w) + h0.w);
    r.z = pack2(x1.x * (1.f + s1.x) + h1.x, x1.y * (1.f + s1.y) + h1.y);
    r.w = pack2(x1.z * (1.f + s1.z) + h1.z, x1.w * (1.f + s1.w) + h1.w);
    return r;
  }
};

constexpr int LDT = 72;
constexpr int LDC = 132;

template <class AL, class EPI>
DI void gemm_tile(const AL& al, const bf16_t* __restrict__ Bt, int K, int m0, int n0, char* smem, const EPI& epi) {
  bf16_t* As = (bf16_t*)smem;
  bf16_t* Bs = As + 128 * LDT;
  float* Cs = (float*)smem;
  const int tid = TIDX(), lane = tid & 63, wave = tid >> 6, wm = wave >> 1, wn = wave & 1;
  const int lr = lane & 31, lh = lane >> 5;
  f32x16 acc[2][2];
#pragma unroll
  for (int i = 0; i < 2; ++i)
#pragma unroll
    for (int j = 0; j < 2; ++j)
#pragma unroll
      for (int r = 0; r < 16; ++r) acc[i][j][r] = 0.f;
  u32x4 ra[4], rb[4];
  const int nkt = K >> 6;
#pragma unroll
  for (int i = 0; i < 4; ++i) {
    const int c = tid + 256 * i, row = c >> 3, kc = (c & 7) * 8;
    ra[i] = al.load(m0 + row, kc);
    rb[i] = *(const u32x4*)(Bt + (size_t)(n0 + row) * K + kc);
  }
  for (int kt = 0; kt < nkt; ++kt) {
    __syncthreads();
#pragma unroll
    for (int i = 0; i < 4; ++i) {
      const int c = tid + 256 * i, row = c >> 3, kc = (c & 7) * 8;
      *(u32x4*)(As + row * LDT + kc) = ra[i];
      *(u32x4*)(Bs + row * LDT + kc) = rb[i];
    }
    __syncthreads();
    if (kt + 1 < nkt) {
      const int k0 = (kt + 1) << 6;
#pragma unroll
      for (int i = 0; i < 4; ++i) {
        const int c = tid + 256 * i, row = c >> 3, kc = (c & 7) * 8;
        ra[i] = al.load(m0 + row, k0 + kc);
        rb[i] = *(const u32x4*)(Bt + (size_t)(n0 + row) * K + k0 + kc);
      }
    }
#pragma unroll
    for (int ks = 0; ks < 4; ++ks) {
      bf16x8 a[2], b[2];
#pragma unroll
      for (int i = 0; i < 2; ++i) a[i] = *(const bf16x8*)(As + (wm * 64 + i * 32 + lr) * LDT + ks * 16 + lh * 8);
#pragma unroll
      for (int j = 0; j < 2; ++j) b[j] = *(const bf16x8*)(Bs + (wn * 64 + j * 32 + lr) * LDT + ks * 16 + lh * 8);
#pragma unroll
      for (int i = 0; i < 2; ++i)
#pragma unroll
        for (int j = 0; j < 2; ++j) acc[i][j] = __builtin_amdgcn_mfma_f32_32x32x16_bf16(a[i], b[j], acc[i][j], 0, 0, 0);
    }
  }
  __syncthreads();
#pragma unroll
  for (int i = 0; i < 2; ++i)
#pragma unroll
    for (int j = 0; j < 2; ++j)
#pragma unroll
      for (int r = 0; r < 16; ++r) {
        const int row = wm * 64 + i * 32 + (r & 3) + 8 * (r >> 2) + 4 * lh, col = wn * 64 + j * 32 + lr;
        Cs[row * LDC + col] = acc[i][j][r];
      }
  __syncthreads();
  epi(Cs, m0, n0);
}


template <class AL, class EPI>
DI void gemm_wide(const AL& al, const bf16_t* __restrict__ Bt, int K, int m0, int n0, int nhalf, char* smem, const EPI& epi) {
  bf16_t* As = (bf16_t*)smem;
  bf16_t* Bs = As + 128 * LDT;
  float* Cs = (float*)smem;
  const int tid = TIDX(), lane = tid & 63, wave = tid >> 6, wm = wave >> 1, wn = wave & 1;
  const int lr = lane & 31, lh = lane >> 5;
  f32x16 acc[2][4];
#pragma unroll
  for (int i = 0; i < 2; ++i)
#pragma unroll
    for (int j = 0; j < 4; ++j)
#pragma unroll
      for (int r = 0; r < 16; ++r) acc[i][j][r] = 0.f;
  u32x4 ra[4], rb[8];
  const int nkt = K >> 6;
#pragma unroll
  for (int i = 0; i < 8; ++i) {
    const int c = tid + 256 * i, row = c >> 3, kc = (c & 7) * 8;
    if (i < 4) ra[i] = al.load(m0 + row, kc);
    rb[i] = *(const u32x4*)(Bt + (size_t)(n0 + row) * K + kc);
  }
#pragma unroll 1
  for (int kt = 0; kt < nkt; ++kt) {
    __syncthreads();
#pragma unroll
    for (int i = 0; i < 8; ++i) {
      const int c = tid + 256 * i, row = c >> 3, kc = (c & 7) * 8;
      if (i < 4) *(u32x4*)(As + row * LDT + kc) = ra[i];
      *(u32x4*)(Bs + row * LDT + kc) = rb[i];
    }
    __syncthreads();
    if (kt + 1 < nkt) {
      const int k0 = (kt + 1) << 6;
#pragma unroll
      for (int i = 0; i < 8; ++i) {
        const int c = tid + 256 * i, row = c >> 3, kc = (c & 7) * 8;
        if (i < 4) ra[i] = al.load(m0 + row, k0 + kc);
        rb[i] = *(const u32x4*)(Bt + (size_t)(n0 + row) * K + k0 + kc);
      }
    }
    {
      bf16x8 a[2][2], b[2][4];
#pragma unroll
      for (int i = 0; i < 2; ++i) a[0][i] = *(const bf16x8*)(As + (wm * 64 + i * 32 + lr) * LDT + lh * 8);
#pragma unroll
      for (int j = 0; j < 4; ++j) b[0][j] = *(const bf16x8*)(Bs + (wn * 128 + j * 32 + lr) * LDT + lh * 8);
#pragma unroll
      for (int ks = 0; ks < 4; ++ks) {
        if (ks + 1 < 4) {
#pragma unroll
          for (int i = 0; i < 2; ++i) a[(ks + 1) & 1][i] = *(const bf16x8*)(As + (wm * 64 + i * 32 + lr) * LDT + (ks + 1) * 16 + lh * 8);
#pragma unroll
          for (int j = 0; j < 4; ++j) b[(ks + 1) & 1][j] = *(const bf16x8*)(Bs + (wn * 128 + j * 32 + lr) * LDT + (ks + 1) * 16 + lh * 8);
        }
#pragma unroll
        for (int i = 0; i < 2; ++i)
#pragma unroll
          for (int j = 0; j < 4; ++j) acc[i][j] = __builtin_amdgcn_mfma_f32_32x32x16_bf16(a[ks & 1][i], b[ks & 1][j], acc[i][j], 0, 0, 0);
        if (ks + 1 < 4) {
#pragma unroll
          for (int g = 0; g < 6; ++g) {
            __builtin_amdgcn_sched_group_barrier(0x100, 1, 0);
            __builtin_amdgcn_sched_group_barrier(0x008, 1, 0);
          }
          __builtin_amdgcn_sched_group_barrier(0x008, 2, 0);
        } else {
          __builtin_amdgcn_sched_group_barrier(0x008, 8, 0);
        }
      }
    }
  }
#pragma unroll
  for (int half = 0; half < 2; ++half) {
    __syncthreads();
    if (wn == half) {
#pragma unroll
      for (int i = 0; i < 2; ++i)
#pragma unroll
        for (int j = 0; j < 4; ++j)
#pragma unroll
          for (int r = 0; r < 16; ++r) {
            const int row = wm * 64 + i * 32 + (r & 3) + 8 * (r >> 2) + 4 * lh, col = j * 32 + lr;
            Cs[row * LDC + col] = acc[i][j][r];
          }
    }
    __syncthreads();
    if (half < nhalf) epi(Cs, m0, n0 + 128 * half);
  }
}

struct EpiInproj {
  const P& p;
  DI void operator()(const float* Cs, int m0, int n0) const {
    const int nt = n0 >> 7, tid = TIDX();
#pragma unroll 1
    for (int pass = 0; pass < 8; ++pass) {
      const int row = pass * 16 + (tid >> 4), c8 = (tid & 15) * 8;
      const size_t tok = (size_t)(m0 + row);
      const int pos = (int)(tok & 8191);
      const float* cr = Cs + row * LDC;
      float v[8];
      if (nt < 4) {
#pragma unroll
        for (int e = 0; e < 8; ++e) v[e] = cr[c8 + e];
        *(uint4*)(p.u_ssm + tok * 512 + nt * 128 + c8) = pack8(v);
      } else if (nt < 14) {
        const float2* rt = p.rope128 + pos * 64;
        if (c8 < 64) {
#pragma unroll
          for (int e = 0; e < 8; ++e) { const int c = c8 + e; const float2 cs = rt[c]; v[e] = cr[c] * cs.x - cr[c + 64] * cs.y; }
        } else {
#pragma unroll
          for (int e = 0; e < 8; ++e) { const int c = c8 + e, cc = c - 64; const float2 cs = rt[cc]; v[e] = cr[c] * cs.x + cr[cc] * cs.y; }
        }
        if (nt < 12) *(uint4*)(p.q + tok * 1024 + (nt - 4) * 128 + c8) = pack8(v);
        else *(uint2*)(p.k8 + tok * 256 + (nt - 12) * 128 + c8) = pack8_fp8(v);
      } else if (nt < 16) {
#pragma unroll
        for (int e = 0; e < 8; ++e) v[e] = cr[c8 + e];
        *(uint2*)(p.v8 + tok * 256 + (nt - 14) * 128 + c8) = pack8_fp8(v);
      } else if (nt < 20 || (nt == 20 && c8 < 64)) {
        const float2* rt = p.rope64 + pos * 32;
        const int cl = c8 & 63;
        if (cl < 32) {
#pragma unroll
          for (int e = 0; e < 8; ++e) { const int c = c8 + e; const float2 cs = rt[cl + e]; v[e] = cr[c] * cs.x - cr[c + 32] * cs.y; }
        } else {
#pragma unroll
          for (int e = 0; e < 8; ++e) { const int c = c8 + e; const float2 cs = rt[cl + e - 32]; v[e] = cr[c] * cs.x + cr[c - 32] * cs.y; }
        }
        bf16_t* dst = (nt < 20) ? (p.qidx + tok * 512 + (nt - 16) * 128 + c8) : (p.kidx + tok * 64 + c8);
        *(uint4*)dst = pack8(v);
      } else if (nt == 20) {
        if (c8 == 64) {
          float4 w0, w1;
          w0.x = cr[64] * IDX_SCALE; w0.y = cr[65] * IDX_SCALE; w0.z = cr[66] * IDX_SCALE; w0.w = cr[67] * IDX_SCALE;
          w1.x = cr[68] * IDX_SCALE; w1.y = cr[69] * IDX_SCALE; w1.z = cr[70] * IDX_SCALE; w1.w = cr[71] * IDX_SCALE;
          *(float4*)(p.widx + tok * 8) = w0; *(float4*)(p.widx + tok * 8 + 4) = w1;
        }
      } else {
#pragma unroll
        for (int e = 0; e < 8; ++e) v[e] = sigm(cr[c8 + e]);
        bf16_t* dst = (nt < 29) ? (p.sg_s + tok * 1024 + (nt - 21) * 128 + c8) : (p.sg_a + tok * 1024 + (nt - 29) * 128 + c8);
        *(uint4*)dst = pack8(v);
      }
    }
  }
};

struct EpiGlu {
  const P& p; const float* bglu;
  DI void operator()(const float* Cs, int m0, int n0) const {
    const int tid = TIDX(), c8 = (tid & 15) * 8, r0 = tid >> 4;
    u32x4 yr[8];
#pragma unroll
    for (int pass = 0; pass < 8; ++pass) yr[pass] = *(const u32x4*)(p.y_pre + (size_t)(m0 + pass * 16 + r0) * 512 + n0 + c8);
    float bg[8];
#pragma unroll
    for (int e = 0; e < 8; ++e) bg[e] = bglu[n0 + c8 + e];
#pragma unroll
    for (int pass = 0; pass < 8; ++pass) {
      const int row = pass * 16 + r0;
      const float* cr = Cs + row * LDC + c8;
      float v[8];
#pragma unroll
      for (int e = 0; e < 8; ++e) {
        const unsigned w = yr[pass][e >> 1];
        const float y = __uint_as_float((e & 1) ? (w & 0xffff0000u) : (w << 16));
        v[e] = y * sigm(cr[e] + bg[e]);
      }
      *(uint4*)(p.y_ssm + (size_t)(m0 + row) * 512 + n0 + c8) = pack8(v);
    }
  }
};

struct EpiMerge1 {
  const P& p;
  DI void operator()(const float* Cs, int m0, int n0) const {
    const int tid = TIDX(), c8 = (tid & 15) * 8, r0 = tid >> 4;
    u32x4 gr[8];
#pragma unroll
    for (int pass = 0; pass < 8; ++pass) gr[pass] = *(const u32x4*)(p.sg_s + (size_t)(m0 + pass * 16 + r0) * 1024 + n0 + c8);
#pragma unroll
    for (int pass = 0; pass < 8; ++pass) {
      const int row = pass * 16 + r0;
      const float* cr = Cs + row * LDC + c8;
      float v[8];
#pragma unroll
      for (int e = 0; e < 8; ++e) {
        const unsigned w = gr[pass][e >> 1];
        const float g = __uint_as_float((e & 1) ? (w & 0xffff0000u) : (w << 16));
        v[e] = g * cr[e];
      }
      *(uint4*)(p.sg_s + (size_t)(m0 + row) * 1024 + n0 + c8) = pack8(v);
    }
  }
};
struct EpiMerge2 {
  const P& p;
  DI void operator()(const float* Cs, int m0, int n0) const {
    const int tid = TIDX(), c8 = (tid & 15) * 8, r0 = tid >> 4;
    u32x4 gr[8], pr[8];
#pragma unroll
    for (int pass = 0; pass < 8; ++pass) {
      gr[pass] = *(const u32x4*)(p.sg_a + (size_t)(m0 + pass * 16 + r0) * 1024 + n0 + c8);
      pr[pass] = *(const u32x4*)(p.sg_s + (size_t)(m0 + pass * 16 + r0) * 1024 + n0 + c8);
    }
#pragma unroll
    for (int pass = 0; pass < 8; ++pass) {
      const int row = pass * 16 + r0;
      const float* cr = Cs + row * LDC + c8;
      float v[8];
#pragma unroll
      for (int e = 0; e < 8; ++e) {
        const unsigned wg = gr[pass][e >> 1], wp = pr[pass][e >> 1];
        const float g = __uint_as_float((e & 1) ? (wg & 0xffff0000u) : (wg << 16));
        const float pa = __uint_as_float((e & 1) ? (wp & 0xffff0000u) : (wp << 16));
        v[e] = pa + g * cr[e];
      }
      *(uint4*)(p.sg_s + (size_t)(m0 + row) * 1024 + n0 + c8) = pack8(v);
    }
  }
};
struct EpiResid {
  const float* xin; const float* gt; float* dst;
  DI void operator()(const float* Cs, int m0, int n0) const {
    const int tid = TIDX(), c8 = (tid & 15) * 8, r0 = tid >> 4;
    const int b = m0 >> 13;
    f32x4 xa[8], xb[8];
#pragma unroll
    for (int pass = 0; pass < 8; ++pass) {
      const f32x4* xs = (const f32x4*)(xin + (size_t)(m0 + pass * 16 + r0) * 1024 + n0 + c8);
      xa[pass] = xs[0]; xb[pass] = xs[1];
    }
    const f32x4* gs = (const f32x4*)(gt + b * 6144 + n0 + c8);
    const f32x4 g0 = gs[0], g1 = gs[1];
#pragma unroll
    for (int pass = 0; pass < 8; ++pass) {
      const int row = pass * 16 + r0;
      const float* cr = Cs + row * LDC + c8;
      f32x4 o0, o1;
#pragma unroll
      for (int e = 0; e < 4; ++e) { o0[e] = ALPHA * xa[pass][e] + (1.f + g0[e]) * cr[e]; o1[e] = ALPHA * xb[pass][e] + (1.f + g1[e]) * cr[4 + e]; }
      f32x4* d = (f32x4*)(dst + (size_t)(m0 + row) * 1024 + n0 + c8);
      d[0] = o0; d[1] = o1;
    }
  }
};
struct EpiGateUp {
  const P& p;
  DI void operator()(const float* Cs, int m0, int n0) const {
    const int tid = TIDX(), j = n0 >> 7;
#pragma unroll 1
    for (int pass = 0; pass < 4; ++pass) {
      const int row = pass * 32 + (tid >> 3), c8 = (tid & 7) * 8;
      const size_t tok = (size_t)(m0 + row);
      const float* cr = Cs + row * LDC + c8;
      float v[8];
#pragma unroll
      for (int e = 0; e < 8; ++e) { const float a = cr[e], bb = cr[64 + e]; v[e] = a * sigm(a) * bb; }
      *(uint4*)(p.act + tok * DFF + j * 64 + c8) = pack8(v);
    }
  }
};

DI int colmap(int mode, int n) {
  if (mode == 0) return n;
  if (mode == 1) return n < 2632 ? n : (n < 2688 ? -1 : (n < 4736 ? n - 56 : -1));
  const int j = n >> 7, r = n & 127;
  return r < 64 ? (64 * j + r) : (2816 + 64 * j + (r - 64));
}
DI void transpose_item(const float* __restrict__ src, int K, int Ns, bf16_t* __restrict__ dst, int mode, int item, char* smem) {
  float* T = (float*)smem;
  const int nkt = K >> 6, kt = item % nkt, nt = item / nkt, k0 = kt * 64, n0 = nt * 64, tid = TIDX();
  __syncthreads();
  {
    const int n = n0 + (tid & 63), sc = colmap(mode, n);
#pragma unroll 4
    for (int rr = 0; rr < 16; ++rr) {
      const int r = rr * 4 + (tid >> 6);
      T[r * 65 + (tid & 63)] = sc >= 0 ? src[(size_t)(k0 + r) * Ns + sc] : 0.f;
    }
  }
  __syncthreads();
#pragma unroll 4
  for (int rr = 0; rr < 16; ++rr) {
    const int nn = rr * 4 + (tid >> 6);
    dst[(size_t)(n0 + nn) * K + k0 + (tid & 63)] = f2bf(T[(tid & 63) * 65 + nn]);
  }
}

constexpr int TR_IN = 76 * 16, TR_GLU = 64, TR_PSSM = 16 * 8, TR_PATTN = 256, TR_OUT = 256, TR_GU = 88 * 16, TR_DOWN = 16 * 44;
constexpr int TR_LAYER = TR_IN + TR_GLU + TR_PSSM + TR_PATTN + TR_OUT + TR_GU + TR_DOWN;
constexpr int N_TR = 2 * TR_LAYER, N_COND = 2 * 192, N_ROPE = 8192 / 8, N_SSMT = (2 * 32 * 64) / 256;
constexpr int N_PRO = N_TR + N_COND + N_ROPE + N_SSMT;

DI void prologue_item(const P& p, int item, char* smem) {
  const int tid = TIDX();
  if (item < N_TR) {
    const int l = item / TR_LAYER; int it = item % TR_LAYER;
    bf16_t* wl = p.wT + (size_t)l * WO_LAYER;
    if (it < TR_IN) { transpose_item(p.w_in + (size_t)l * 1024 * 4680, 1024, 4680, wl + WO_IN, 1, it, smem); return; } it -= TR_IN;
    if (it < TR_GLU) { transpose_item(p.w_glu + (size_t)l * 512 * 512, 512, 512, wl + WO_GLU, 0, it, smem); return; } it -= TR_GLU;
    if (it < TR_PSSM) { transpose_item(p.p_ssm + (size_t)l * 512 * 1024, 512, 1024, wl + WO_PSSM, 0, it, smem); return; } it -= TR_PSSM;
    if (it < TR_PATTN) { transpose_item(p.p_attn + (size_t)l * 1024 * 1024, 1024, 1024, wl + WO_PATTN, 0, it, smem); return; } it -= TR_PATTN;
    if (it < TR_OUT) { transpose_item(p.w_out + (size_t)l * 1024 * 1024, 1024, 1024, wl + WO_OUT, 0, it, smem); return; } it -= TR_OUT;
    if (it < TR_GU) { transpose_item(p.w_gu + (size_t)l * 1024 * 5632, 1024, 5632, wl + WO_GU, 2, it, smem); return; } it -= TR_GU;
    transpose_item(p.w_down + (size_t)l * DFF * 1024, DFF, 1024, wl + WO_DOWN, 0, it, smem); return;
  }
  item -= N_TR;
  if (item < N_COND) {
    const int l = item / 192, n0 = (item % 192) * 32;
    float* sc = (float*)smem;
    float* red = sc + 8192;
    __syncthreads();
    for (int i = tid; i < 8192; i += 256) { const float cv = p.c[i]; sc[i] = cv * sigm(cv); }
    __syncthreads();
    const int nn = tid & 31, kc = tid >> 5;
    float acc[8];
#pragma unroll
    for (int b = 0; b < 8; ++b) acc[b] = 0.f;
    const float* wp = p.w_cond + ((size_t)l * 1024 + kc * 128) * 6144 + n0 + nn;
    for (int k = 0; k < 128; ++k) {
      const float w = wp[(size_t)k * 6144];
#pragma unroll
      for (int b = 0; b < 8; ++b) acc[b] += sc[b * 1024 + kc * 128 + k] * w;
    }
#pragma unroll
    for (int b = 0; b < 8; ++b) red[(kc * 8 + b) * 32 + nn] = acc[b];
    __syncthreads();
    {
      const int b = tid >> 5;
      float s = 0.f;
#pragma unroll
      for (int q = 0; q < 8; ++q) s += red[(q * 8 + b) * 32 + nn];
      p.mod[((size_t)l * 8 + b) * 6144 + n0 + nn] = s + p.b_cond[l * 6144 + n0 + nn];
    }
    return;
  }
  item -= N_COND;
  if (item < N_ROPE) {
#pragma unroll 1
    for (int k = 0; k < 3; ++k) {
      const int e = tid + 256 * k;
      const int pos = item * 8 + e / 96, j = e % 96;
      if (j < 64) {
        const float inv = (float)pow(10000.0, -(double)j / 64.0);
        const float ang = (float)pos * inv;
        p.rope128[pos * 64 + j] = make_float2((float)cos((double)ang), (float)sin((double)ang));
      } else {
        const int i = j - 64;
        const float inv = (float)pow(10000.0, -(double)i / 32.0);
        const float ang = (float)pos * inv;
        p.rope64[pos * 32 + i] = make_float2((float)cos((double)ang), (float)sin((double)ang));
      }
    }
    return;
  }
  item -= N_ROPE;
  {
    const int idx = item * 256 + tid;
    const int lg = idx >> 6;
    const double dt = exp((double)p.log_dt[lg]);
    const double lr = p.lam_re[idx], li = p.lam_im[idx];
    const double mag = exp(lr * dt), ar = mag * cos(li * dt), ai = mag * sin(li * dt);
    const double mag128 = exp(lr * dt * 128.0), ar128 = mag128 * cos(li * dt * 128.0), ai128 = mag128 * sin(li * dt * 128.0);
    const double den = lr * lr + li * li, nr = ar - 1.0;
    const double fr = (nr * lr + ai * li) / den, fi = (ai * lr - nr * li) / den;
    p.ssmA[idx] = make_float4((float)ar, (float)ai, (float)ar128, (float)ai128);
    for (int i = 0; i < 16; ++i) {
      const double br = p.b_re[(size_t)idx * 16 + i], bi = p.b_im[(size_t)idx * 16 + i];
      p.ssmB[(size_t)idx * 16 + i] = make_float2((float)(fr * br - fi * bi), (float)(fr * bi + fi * br));
    }
  }
}

template <bool FULL>
DI void ssm_item(const P& p, int l, int item, char* smem) {
  const int tid = TIDX(), lane = tid & 63, wave = tid >> 6;
  const int b = item >> 9, c = (item >> 3) & 63, g = (item & 7) * 4 + wave;
  float* H = (float*)smem + wave * (16 * 132 + 256);
  float* us = H + 16 * 132;
  const int lg = l * 32 + g;
  const float4 a4 = p.ssmA[lg * 64 + lane];
  const float ar = a4.x, ai = a4.y;
  float bbr[16], bbi[16];
  {
    const float4* bp = (const float4*)(p.ssmB + ((size_t)lg * 64 + lane) * 16);
#pragma unroll
    for (int i = 0; i < 8; ++i) { const float4 t = bp[i]; bbr[2 * i] = t.x; bbi[2 * i] = t.y; bbr[2 * i + 1] = t.z; bbi[2 * i + 1] = t.w; }
  }
  float hr = 0.f, hi = 0.f;
  const int ch = lane & 15, quad = lane >> 4;
  float creg[32];
  float dsk = 0.f;
  if (FULL) {
    const float2* Ep = p.E + ((size_t)(b * 32 + g) * 64) * 64 + lane;
    for (int cc = 0; cc < c; ++cc) {
      const float2 e = Ep[cc * 64];
      const float nhr = a4.z * hr - a4.w * hi + e.x, nhi = a4.z * hi + a4.w * hr + e.y;
      hr = nhr; hi = nhi;
    }
    const float* cp = (quad < 2 ? p.c_re : p.c_im) + ((size_t)lg * 16 + ch) * 64 + (quad & 1) * 32;
    const float sgn = quad < 2 ? 1.f : -1.f;
#pragma unroll
    for (int i = 0; i < 8; ++i) { const float4 t = ((const float4*)cp)[i]; creg[4 * i] = sgn * t.x; creg[4 * i + 1] = sgn * t.y; creg[4 * i + 2] = sgn * t.z; creg[4 * i + 3] = sgn * t.w; }
    dsk = p.d_skip[l * 512 + g * 16 + ch];
  }
  const size_t tok0 = (size_t)b * SEQ + c * 128;
#pragma unroll 1
  for (int s = 0; s < 8; ++s) {
    const int tt = lane >> 2, part = lane & 3;
    const uint2 raw = *(const uint2*)(p.u_ssm + (tok0 + s * 16 + tt) * 512 + g * 16 + part * 4);
    float4 uf;
    uf.x = __uint_as_float(raw.x << 16); uf.y = __uint_as_float(raw.x & 0xffff0000u);
    uf.z = __uint_as_float(raw.y << 16); uf.w = __uint_as_float(raw.y & 0xffff0000u);
    __syncthreads();
    *(float4*)(us + tt * 16 + part * 4) = uf;
    __syncthreads();
#pragma unroll 4
    for (int t = 0; t < 16; ++t) {
      const float4* up = (const float4*)(us + t * 16);
      const float4 u0 = up[0], u1 = up[1], u2 = up[2], u3 = up[3];
      const float uu[16] = {u0.x, u0.y, u0.z, u0.w, u1.x, u1.y, u1.z, u1.w, u2.x, u2.y, u2.z, u2.w, u3.x, u3.y, u3.z, u3.w};
      float br = 0.f, bi = 0.f;
#pragma unroll
      for (int i = 0; i < 16; ++i) { br = fmaf(bbr[i], uu[i], br); bi = fmaf(bbi[i], uu[i], bi); }
      const float nhr = ar * hr - ai * hi + br, nhi = ar * hi + ai * hr + bi;
      hr = nhr; hi = nhi;
      if (FULL) { H[t * 132 + lane] = hr; H[t * 132 + 64 + lane] = hi; }
    }
    if (FULL) {
      __syncthreads();
      f32x4 acc = {0.f, 0.f, 0.f, 0.f};
      const float* hp = H + ch * 132 + quad * 32;
#pragma unroll
      for (int i = 0; i < 8; ++i) {
        const float4 hv = *(const float4*)(hp + 4 * i);
        acc = __builtin_amdgcn_mfma_f32_16x16x4f32(hv.x, creg[4 * i], acc, 0, 0, 0);
        acc = __builtin_amdgcn_mfma_f32_16x16x4f32(hv.y, creg[4 * i + 1], acc, 0, 0, 0);
        acc = __builtin_amdgcn_mfma_f32_16x16x4f32(hv.z, creg[4 * i + 2], acc, 0, 0, 0);
        acc = __builtin_amdgcn_mfma_f32_16x16x4f32(hv.w, creg[4 * i + 3], acc, 0, 0, 0);
      }
#pragma unroll
      for (int r = 0; r < 4; ++r) {
        const int tl = quad * 4 + r;
        float y = acc[r] + dsk * us[tl * 16 + ch];
        const float y3 = y * y * y;
        y = y * sigm(1.5957691216057308f * (y + 0.044715f * y3));
        p.y_pre[(tok0 + s * 16 + tl) * 512 + g * 16 + ch] = f2bf(y);
      }
    }
  }
  if (!FULL) p.E[((size_t)(b * 32 + g) * 64 + c) * 64 + lane] = make_float2(hr, hi);
}

DI unsigned mono(float f) { const unsigned u = __float_as_uint(f); return (u & 0x80000000u) ? ~u : (u | 0x80000000u); }

DI void select_item(const P& p, int b, int quad4, int bid, char* smem) {
  const int t0 = quad4 * 4;
  if (t0 < 256) return;
  const int tid = TIDX(), lane = tid & 63, wave = tid >> 6;
  unsigned* hist = (unsigned*)smem + wave * 256;
  unsigned* candi = (unsigned*)smem + 1024 + wave * 512;
  unsigned* candk = candi + 256;
  unsigned short* sc16 = (unsigned short*)((unsigned*)smem + 3072);
  unsigned* scr = p.scr + (size_t)bid * 4 * 8192;
  const size_t tok0 = (size_t)b * SEQ + t0;
  __syncthreads();
  {
    const int r = lane & 31, h = lane >> 5;
    bf16x8 a[4];
    {
      const bf16_t* qp = p.qidx + (tok0 + (r >> 3)) * 512 + (r & 7) * 64 + h * 8;
#pragma unroll
      for (int s = 0; s < 4; ++s) a[s] = *(const bf16x8*)(qp + s * 16);
    }
    float4 w[4];
#pragma unroll
    for (int q = 0; q < 4; ++q) w[q] = *(const float4*)(p.widx + (tok0 + q) * 8 + h * 4);
    const int ntile = (t0 + 4 + 31) >> 5;
    const bf16_t* kbase = p.kidx + ((size_t)b * SEQ) * 64 + h * 8;
    const int nit = (ntile - wave + 3) >> 2;
#pragma unroll 1
    for (int i0 = 0; i0 < nit; i0 += 4) {
      bf16x8 bf[4][4];
#pragma unroll
      for (int u = 0; u < 4; ++u) {
        int kt = wave + 4 * (i0 + u); kt = kt < ntile ? kt : ntile - 1;
        const bf16_t* kp = kbase + (size_t)(kt * 32 + r) * 64;
#pragma unroll
        for (int s = 0; s < 4; ++s) bf[u][s] = *(const bf16x8*)(kp + s * 16);
      }
#pragma unroll
      for (int u = 0; u < 4; ++u) {
        const int key = (wave + 4 * (i0 + u)) * 32 + r;
        f32x16 acc;
#pragma unroll
        for (int i = 0; i < 16; ++i) acc[i] = 0.f;
#pragma unroll
        for (int s = 0; s < 4; ++s) acc = __builtin_amdgcn_mfma_f32_32x32x16_bf16(a[s], bf[u][s], acc, 0, 0, 0);
        float tot[4];
#pragma unroll
        for (int q = 0; q < 4; ++q) {
          float sq = 0.f;
          sq = fmaf(fmaxf(acc[4 * q + 0], 0.f), w[q].x, sq); sq = fmaf(fmaxf(acc[4 * q + 1], 0.f), w[q].y, sq);
          sq = fmaf(fmaxf(acc[4 * q + 2], 0.f), w[q].z, sq); sq = fmaf(fmaxf(acc[4 * q + 3], 0.f), w[q].w, sq);
          tot[q] = sq + __shfl_xor(sq, 32);
        }
        if (i0 + u < nit) {
          const unsigned m0 = mono(h == 0 ? tot[0] : tot[2]), m1 = mono(h == 0 ? tot[1] : tot[3]);
          const int q0 = h * 2;
          sc16[q0 * 8192 + key] = (unsigned short)(m0 >> 16); sc16[(q0 + 1) * 8192 + key] = (unsigned short)(m1 >> 16);
          __builtin_nontemporal_store(m0, scr + q0 * 8192 + key); __builtin_nontemporal_store(m1, scr + (q0 + 1) * 8192 + key);
        }
      }
    }
  }
  __syncthreads();
  {
    const int qi = wave, n = t0 + qi + 1;
    const unsigned short* s = sc16 + qi * 8192;
    const unsigned* s32 = (const unsigned*)s;
    unsigned prefix = 0, pmask = 0, need = 256, eq_total = 0;
#pragma unroll 1
    for (int pass = 0; pass < 2; ++pass) {
      const int shift = 8 - 8 * pass;
#pragma unroll
      for (int k = 0; k < 4; ++k) hist[lane + 64 * k] = 0;
      __builtin_amdgcn_wave_barrier();
      for (int e2 = lane; 2 * e2 < n; e2 += 64) {
        const unsigned wv = s32[e2];
        const unsigned k0 = wv & 0xffffu, k1 = wv >> 16;
        if ((k0 & pmask) == prefix) atomicAdd(&hist[(k0 >> shift) & 255], 1u);
        if (2 * e2 + 1 < n && (k1 & pmask) == prefix) atomicAdd(&hist[(k1 >> shift) & 255], 1u);
      }
      __builtin_amdgcn_wave_barrier();
      const uint4 h4 = *(const uint4*)(hist + 4 * lane);
      const unsigned sum = h4.x + h4.y + h4.z + h4.w;
      unsigned incl = sum;
#pragma unroll
      for (int off = 1; off < 64; off <<= 1) { const unsigned v = __shfl_down(incl, off); if (lane + off < 64) incl += v; }
      unsigned above = incl - sum;
      const bool found = above < need && need <= incl;
      unsigned dig = 0, cnt = 0;
      if (found) {
        if (above + h4.w >= need) { dig = 3; cnt = h4.w; }
        else { above += h4.w;
          if (above + h4.z >= need) { dig = 2; cnt = h4.z; }
          else { above += h4.z;
            if (above + h4.y >= need) { dig = 1; cnt = h4.y; }
            else { above += h4.y; dig = 0; cnt = h4.x; } } }
        dig += 4 * lane;
      }
      const unsigned long long fb = __ballot(found);
      const int fl = fb ? (__ffsll((long long)fb) - 1) : 0;
      const unsigned dsel = __shfl(dig, fl), nneed = __shfl(need - above, fl), ncnt = __shfl(cnt, fl);
      prefix |= dsel << shift; pmask |= 0xffu << shift; need = nneed; eq_total = ncnt;
      __builtin_amdgcn_wave_barrier();
    }
    const unsigned thr = prefix, ngt = 256 - need;
    unsigned short* dst = p.sel + (tok0 + qi) * 256;
    const unsigned long long lm = (1ull << lane) - 1ull;
    unsigned og = 0, oe = 0;
    for (int base = 0; base < n; base += 64) {
      const int e = base + lane;
      const unsigned u = e < n ? (unsigned)s[e] : 0u;
      const bool isg = e < n && u > thr, ise = e < n && u == thr;
      const unsigned long long bg = __ballot(isg), be = __ballot(ise);
      if (isg) { const unsigned pos = og + __popcll(bg & lm); if (pos < 256u) dst[pos] = (unsigned short)e; }
      if (ise) { const unsigned rr = oe + __popcll(be & lm); if (rr < 256u) candi[rr] = (unsigned)e; }
      og += __popcll(bg); oe += __popcll(be);
    }
    __builtin_amdgcn_wave_barrier();
    const unsigned c = eq_total < 256u ? eq_total : 256u;
    if (eq_total == need) {
      for (unsigned i = lane; i < c; i += 64) if (ngt + i < 256u) dst[ngt + i] = (unsigned short)candi[i];
    } else {
      for (unsigned i = lane; i < c; i += 64) candk[i] = __hip_atomic_load(scr + qi * 8192 + candi[i], __ATOMIC_RELAXED, __HIP_MEMORY_SCOPE_AGENT);
      __builtin_amdgcn_wave_barrier();
      for (unsigned i = lane; i < c; i += 64) {
        const unsigned ki = candk[i];
        unsigned rank = 0;
        for (unsigned j2 = 0; j2 < c; ++j2) { const unsigned kj = candk[j2]; rank += (kj > ki || (kj == ki && j2 < i)) ? 1u : 0u; }
        if (rank < need && ngt + rank < 256u) dst[ngt + rank] = (unsigned short)candi[i];
      }
    }
  }
  __syncthreads();
}

DI void attn_item(const P& p, int b, int kvh, int quad4, char* smem) {
  const int tid = TIDX(), lane = tid & 63, wave = tid >> 6;
  const int t = quad4 * 4 + wave;
  const size_t tok = (size_t)b * SEQ + t;
  float* L = (float*)smem + wave * (1024 + 256);
  int* idx = (int*)(L + 1024);
  const int cnt = t < 256 ? t + 1 : 256;
  __syncthreads();
  if (t < 256) {
#pragma unroll
    for (int j = 0; j < 4; ++j) { const int n = lane + 64 * j; idx[n] = n < cnt ? n : 0; }
  } else {
    const uint2 sv = *(const uint2*)(p.sel + tok * 256 + lane * 4);
    idx[lane * 4 + 0] = sv.x & 0xffff; idx[lane * 4 + 1] = sv.x >> 16; idx[lane * 4 + 2] = sv.y & 0xffff; idx[lane * 4 + 3] = sv.y >> 16;
  }
  const int r = lane & 15, quad = lane >> 4;
  long qa8[4];
  {
    const bf16_t* qp = p.q + tok * 1024 + (kvh * 4 + (r & 3)) * 128 + quad * 16;
#pragma unroll
    for (int s = 0; s < 4; ++s) {
      const u32x4 tq = *(const u32x4*)(qp + (s >> 1) * 64 + (s & 1) * 8);
      float f[8];
#pragma unroll
      for (int e = 0; e < 4; ++e) { f[2 * e] = __uint_as_float(tq[e] << 16); f[2 * e + 1] = __uint_as_float(tq[e] & 0xffff0000u); }
      const uint2 pk = pack8_fp8(f);
      long v = (long)(((unsigned long long)pk.y << 32) | (unsigned long long)pk.x);
      if (r >= 4) v = 0;
      qa8[s] = v;
    }
  }
  __syncthreads();
  const unsigned char* kb = p.k8 + ((size_t)b * SEQ) * 256 + kvh * 128 + quad * 16;
  int myidx[16];
#pragma unroll
  for (int kt = 0; kt < 16; ++kt) myidx[kt] = idx[kt * 16 + r];
#pragma unroll
  for (int kt0 = 0; kt0 < 16; kt0 += 8) {
    u32x4 kraw[8][2];
#pragma unroll
    for (int u = 0; u < 8; ++u) {
      const unsigned char* kp = kb + (size_t)myidx[kt0 + u] * 256;
      kraw[u][0] = *(const u32x4*)kp; kraw[u][1] = *(const u32x4*)(kp + 64);
    }
#pragma unroll
    for (int u = 0; u < 8; ++u) {
      const int n = (kt0 + u) * 16 + r;
      f32x4 acc = {0.f, 0.f, 0.f, 0.f};
#pragma unroll
      for (int S = 0; S < 2; ++S) {
        const long k0 = (long)(((unsigned long long)kraw[u][S][1] << 32) | (unsigned long long)kraw[u][S][0]);
        const long k1 = (long)(((unsigned long long)kraw[u][S][3] << 32) | (unsigned long long)kraw[u][S][2]);
        acc = __builtin_amdgcn_mfma_f32_16x16x32_fp8_fp8(qa8[2 * S], k0, acc, 0, 0, 0);
        acc = __builtin_amdgcn_mfma_f32_16x16x32_fp8_fp8(qa8[2 * S + 1], k1, acc, 0, 0, 0);
      }
      if (quad == 0) {
        const bool ok = n < cnt;
#pragma unroll
        for (int h = 0; h < 4; ++h) L[h * 256 + n] = ok ? acc[h] * ATT_SCALE : -INFINITY;
      }
    }
  }
  __syncthreads();
  float pr[4][4];
#pragma unroll
  for (int h = 0; h < 4; ++h) {
    float m = -INFINITY;
#pragma unroll
    for (int j = 0; j < 4; ++j) { pr[h][j] = L[h * 256 + lane + 64 * j]; m = fmaxf(m, pr[h][j]); }
#pragma unroll
    for (int off = 32; off >= 1; off >>= 1) m = fmaxf(m, __shfl_xor(m, off));
    float sum = 0.f;
#pragma unroll
    for (int j = 0; j < 4; ++j) { pr[h][j] = __expf(pr[h][j] - m); sum += pr[h][j]; }
#pragma unroll
    for (int off = 32; off >= 1; off >>= 1) sum += __shfl_xor(sum, off);
    const float inv = 1.f / sum;
#pragma unroll
    for (int j = 0; j < 4; ++j) pr[h][j] *= inv;
  }
  __syncthreads();
#pragma unroll
  for (int j = 0; j < 4; ++j) *(float4*)(L + (lane + 64 * j) * 4) = make_float4(pr[0][j], pr[1][j], pr[2][j], pr[3][j]);
  __syncthreads();
  float o[4][8];
#pragma unroll
  for (int h = 0; h < 4; ++h)
#pragma unroll
    for (int e = 0; e < 8; ++e) o[h][e] = 0.f;
  const unsigned char* vb = p.v8 + ((size_t)b * SEQ) * 256 + kvh * 128 + r * 8;
#pragma unroll 1
  for (int n0 = 0; n0 < 256; n0 += 64) {
    uint2 vv[16];
#pragma unroll
    for (int u = 0; u < 16; ++u) vv[u] = *(const uint2*)(vb + (size_t)idx[n0 + 4 * u + quad] * 256);
#pragma unroll
    for (int u = 0; u < 16; ++u) {
      const float4 p4 = *(const float4*)(L + (n0 + 4 * u + quad) * 4);
      const f32x2_t c0 = __builtin_amdgcn_cvt_pk_f32_fp8((int)vv[u].x, false), c1 = __builtin_amdgcn_cvt_pk_f32_fp8((int)vv[u].x, true);
      const f32x2_t c2 = __builtin_amdgcn_cvt_pk_f32_fp8((int)vv[u].y, false), c3 = __builtin_amdgcn_cvt_pk_f32_fp8((int)vv[u].y, true);
      const float vf[8] = {c0.x, c0.y, c1.x, c1.y, c2.x, c2.y, c3.x, c3.y};
#pragma unroll
      for (int e = 0; e < 8; ++e) {
        o[0][e] = fmaf(p4.x, vf[e], o[0][e]); o[1][e] = fmaf(p4.y, vf[e], o[1][e]);
        o[2][e] = fmaf(p4.z, vf[e], o[2][e]); o[3][e] = fmaf(p4.w, vf[e], o[3][e]);
      }
    }
  }
#pragma unroll
  for (int h = 0; h < 4; ++h)
#pragma unroll
    for (int e = 0; e < 8; ++e) { float v = o[h][e]; v += __shfl_xor(v, 16); v += __shfl_xor(v, 32); o[h][e] = v; }
  if (quad == 0) {
#pragma unroll
    for (int h = 0; h < 4; ++h) *(uint4*)(p.q + tok * 1024 + (kvh * 4 + h) * 128 + r * 8) = pack8(o[h]);
  }
}

template <int GRP>
DI void ln_items(float* X, const float* gam, const float* bet, bf16_t* u2, const float* sc, const float* sh, int item0) {
  const int tid = TIDX(), lane = tid & 63, wave = tid >> 6;
  f32x4 v[GRP][4];
#pragma unroll
  for (int g = 0; g < GRP; ++g) {
    const size_t tok = (size_t)(item0 + g) * 4 + wave;
#pragma unroll
    for (int j = 0; j < 4; ++j) v[g][j] = *(const f32x4*)(X + tok * 1024 + j * 256 + lane * 4);
  }
#pragma unroll
  for (int g = 0; g < GRP; ++g) {
    const size_t tok = (size_t)(item0 + g) * 4 + wave;
    const int b = (int)(tok >> 13);
    float s = 0.f;
#pragma unroll
    for (int j = 0; j < 4; ++j) s += v[g][j][0] + v[g][j][1] + v[g][j][2] + v[g][j][3];
#pragma unroll
    for (int off = 32; off >= 1; off >>= 1) s += __shfl_xor(s, off);
    const float mu = s * (1.f / 1024.f);
    float q = 0.f;
#pragma unroll
    for (int j = 0; j < 4; ++j)
#pragma unroll
      for (int e = 0; e < 4; ++e) { const float d = v[g][j][e] - mu; q += d * d; }
#pragma unroll
    for (int off = 32; off >= 1; off >>= 1) q += __shfl_xor(q, off);
    const float rstd = rsqrtf(q * (1.f / 1024.f) + 1e-5f);
#pragma unroll
    for (int j = 0; j < 4; ++j) {
      const int col = j * 256 + lane * 4;
      const f32x4 gg = *(const f32x4*)(gam + col), be = *(const f32x4*)(bet + col);
      f32x4 y;
#pragma unroll
      for (int e = 0; e < 4; ++e) y[e] = (v[g][j][e] - mu) * rstd * gg[e] + be[e];
      *(f32x4*)(X + tok * 1024 + col) = y;
      if (u2) {
        const f32x4 s4 = *(const f32x4*)(sc + b * 6144 + col), h4 = *(const f32x4*)(sh + b * 6144 + col);
        uint2 o;
        o.x = pack2(y[0] * (1.f + s4[0]) + h4[0], y[1] * (1.f + s4[1]) + h4[1]);
        o.y = pack2(y[2] * (1.f + s4[2]) + h4[2], y[3] * (1.f + s4[3]) + h4[3]);
        *(uint2*)(u2 + tok * 1024 + col) = o;
      }
    }
  }
}

enum { PH_PRO = 0, PH_U1, PH_INPROJ, PH_SEL, PH_SSMA, PH_ATTN, PH_SSMB, PH_CHA, PH_CHB, PH_COUNT };

DI void run_phase(const P& p, int ph, int l, int bid, int nblk, char* smem) {
  const float* modl = p.mod + (size_t)l * 8 * 6144;
  const bf16_t* wl = p.wT + (size_t)l * WO_LAYER;
  const float* xin = (l == 0) ? p.x : p.out;
  switch (ph) {
    case PH_PRO:
      for (int it = bid; it < N_PRO; it += nblk) prologue_item(p, it, smem);
      break;
    case PH_U1:
      for (int it = bid; it < NTOK / 2; it += nblk) {
        const size_t e0 = (size_t)it * 2048 + TIDX() * 8;
        const int b = (int)(e0 >> 23), col = (int)(e0 & 1023);
        const float4 x0 = *(const float4*)(xin + e0), x1 = *(const float4*)(xin + e0 + 4);
        const float4 s0 = *(const float4*)(modl + b * 6144 + 1024 + col), s1 = *(const float4*)(modl + b * 6144 + 1024 + col + 4);
        const float4 h0 = *(const float4*)(modl + b * 6144 + col), h1 = *(const float4*)(modl + b * 6144 + col + 4);
        uint4 r;
        r.x = pack2(x0.x * (1.f + s0.x) + h0.x, x0.y * (1.f + s0.y) + h0.y);
        r.y = pack2(x0.z * (1.f + s0.z) + h0.z, x0.w * (1.f + s0.w) + h0.w);
        r.z = pack2(x1.x * (1.f + s1.x) + h1.x, x1.y * (1.f + s1.y) + h1.y);
        r.w = pack2(x1.z * (1.f + s1.z) + h1.z, x1.w * (1.f + s1.w) + h1.w);
        *(uint4*)((bf16_t*)p.XA + e0) = r;
      }
      break;
    case PH_INPROJ: {
      ALoadBf16 al{(const bf16_t*)p.XA, 1024};
      EpiInproj epi{p};
      if ((nblk & 7) == 0) {
        const int x = bid & 7, j = bid >> 3, nj = nblk >> 3;
        for (int i = j; i < 64 * 19; i += nj) gemm_wide(al, wl + WO_IN, 1024, (x + 8 * (i / 19)) * 128, (i % 19) * 256, (i % 19) == 18 ? 1 : 2, smem, epi);
      } else {
        for (int it = bid; it < 512 * 19; it += nblk) gemm_wide(al, wl + WO_IN, 1024, (it / 19) * 128, (it % 19) * 256, (it % 19) == 18 ? 1 : 2, smem, epi);
      }
    } break;
    case PH_SEL:
      if ((nblk & 7) == 0) {
        const int b = bid & 7, j = bid >> 3, nj = nblk >> 3;
        for (int i = j; i < 2048; i += nj) select_item(p, b, 2047 - i, bid, smem);
      } else {
        for (int it = bid; it < 16384; it += nblk) select_item(p, it >> 11, 2047 - (it & 2047), bid, smem);
      }
      break;
    case PH_SSMA:
      for (int it = bid; it < 4096; it += nblk) ssm_item<false>(p, l, it, smem);
      break;
    case PH_ATTN:
      if ((nblk & 7) == 0) {
        const int b = bid & 7, j = bid >> 3, nj = nblk >> 3;
        for (int i = j; i < 4096; i += nj) attn_item(p, b, i >> 11, i & 2047, smem);
      } else {
        for (int it = bid; it < 32768; it += nblk) attn_item(p, it >> 12, (it >> 11) & 1, it & 2047, smem);
      }
      break;
    case PH_SSMB:
      for (int it = bid; it < 4096; it += nblk) ssm_item<true>(p, l, it, smem);
      break;
    case PH_CHA: {
      ALoadBf16 aglu{p.y_pre, 512}, a1{p.y_ssm, 512}, a2{p.q, 1024}, aout{p.sg_s, 1024};
      EpiGlu eglu{p, p.b_glu + l * 512};
      EpiMerge1 e1{p}; EpiMerge2 e2{p};
      EpiResid eres{xin, modl + 2048, p.XA};
#pragma unroll 1
      for (int m = bid; m < 512; m += nblk) {
        const int m0 = m * 128;
#pragma unroll 1
        for (int n = 0; n < 2; ++n) gemm_wide(aglu, wl + WO_GLU, 512, m0, n * 256, 2, smem, eglu);
        __syncthreads();
#pragma unroll 1
        for (int n = 0; n < 4; ++n) {
          gemm_wide(a1, wl + WO_PSSM, 512, m0, n * 256, 2, smem, e1);
          gemm_wide(a2, wl + WO_PATTN, 1024, m0, n * 256, 2, smem, e2);
        }
        __syncthreads();
#pragma unroll 1
        for (int n = 0; n < 4; ++n) gemm_wide(aout, wl + WO_OUT, 1024, m0, n * 256, 2, smem, eres);
        __syncthreads();
#pragma unroll 1
        for (int i = 0; i < 32; i += 4) ln_items<4>(p.XA, p.ln1_g + l * 1024, p.ln1_b + l * 1024, p.u2, modl + 4096, modl + 3072, m * 32 + i);
        __syncthreads();
      }
    } break;
    case PH_CHB: {
      ALoadBf16 agu{p.u2, 1024}, adn{p.act, DFF};
      EpiGateUp egu{p};
      EpiResid eres{p.XA, modl + 5120, p.out};
#pragma unroll 1
      for (int m = bid; m < 512; m += nblk) {
        const int m0 = m * 128;
#pragma unroll 1
        for (int n = 0; n < 22; ++n) gemm_wide(agu, wl + WO_GU, 1024, m0, ((n + (m & 3)) % 22) * 256, 2, smem, egu);
        __syncthreads();
#pragma unroll 1
        for (int n = 0; n < 4; ++n) gemm_wide(adn, wl + WO_DOWN, DFF, m0, n * 256, 2, smem, eres);
        __syncthreads();
#pragma unroll 1
        for (int i = 0; i < 32; i += 4) ln_items<4>(p.out, p.ln2_g + l * 1024, p.ln2_b + l * 1024, nullptr, nullptr, nullptr, m * 32 + i);
        __syncthreads();
      }
    } break;
  }
}

template <int PH> __global__ void __launch_bounds__(256, 2) k_phase(P p, int l) {
  extern __shared__ __attribute__((aligned(16))) char smem[];
  run_phase(p, PH, l, blockIdx.x, gridDim.x, smem);
}
template <int PH> static void launch_phase(const P& p, int l, int G, hipStream_t stream) {
  static bool attr = false;
  if (!attr) { attr = true; (void)hipFuncSetAttribute((const void*)k_phase<PH>, hipFuncAttributeMaxDynamicSharedMemorySize, LDS_BYTES); }
  hipLaunchKernelGGL((k_phase<PH>), dim3(G), dim3(256), LDS_BYTES, stream, p, l);
}

#if MEGA
__global__ void __launch_bounds__(256, 2) k_mega(P p) {
  extern __shared__ __attribute__((aligned(16))) char smem[];
  cg::grid_group grid = cg::this_grid();
  run_phase(p, PH_PRO, 0, blockIdx.x, gridDim.x, smem);
  grid.sync();
#pragma unroll 1
  for (int l = 0; l < 2; ++l) {
#pragma unroll 1
    for (int ph = PH_U1; ph < PH_COUNT; ++ph) {
      run_phase(p, ph, l, blockIdx.x, gridDim.x, smem);
      if (!(l == 1 && ph == PH_CHB)) grid.sync();
    }
  }
}
#endif


extern "C" void kernel_launch(void* const* d_in, const int* in_sizes, int n_in, void* d_out, int out_size, void* d_ws, size_t ws_size, hipStream_t stream) {
  constexpr size_t MiB = 1ull << 20;
  size_t off = 0;
  auto take = [&](size_t bytes) { size_t o = off; off += (bytes + 255) & ~(size_t)255; return o; };
  const size_t o_wT = take(2 * WO_LAYER * 2);
  const size_t o_rope128 = take(8192 * 64 * 8), o_rope64 = take(8192 * 32 * 8);
  const size_t o_ssmA = take(2 * 32 * 64 * 16), o_ssmB = take(2 * 32 * 64 * 16 * 8), o_mod = take(2 * 8 * 6144 * 4), o_E = take((size_t)8 * 32 * 64 * 64 * 8);
  const size_t o_XA = take((size_t)NTOK * 1024 * 4);
  const size_t o_sel = take((size_t)NTOK * 256 * 2);
  const size_t o_P = off;
  const size_t o_ussm = take((size_t)NTOK * 512 * 2), o_q = take((size_t)NTOK * 1024 * 2), o_k = take((size_t)NTOK * 256 * 2), o_v = take((size_t)NTOK * 256 * 2);
  const size_t o_qidx = take((size_t)NTOK * 512 * 2), o_kidx = take((size_t)NTOK * 64 * 2), o_widx = take((size_t)NTOK * 8 * 4);
  const size_t o_sgs = take((size_t)NTOK * 1024 * 2), o_sga = take((size_t)NTOK * 1024 * 2);
  const size_t o_scr = take((size_t)512 * 4 * 8192 * 4);
  const size_t total = off;
  static int state = 0, grid_blocks = 0;
  if (state == 0) {
    state = 1;
    if (n_in != 24 || out_size != NTOK * 1024 || ws_size < total) {
      fprintf(stderr, "kernel_launch: unexpected sizes n_in %d out %d ws %zu (need %zu)\n", n_in, out_size, ws_size, total);
      state = -1;
    } else {
      int dev = 0, cus = 0, per_cu = 0;
      hipGetDevice(&dev);
      hipDeviceGetAttribute(&cus, hipDeviceAttributeMultiprocessorCount, dev);
#if MEGA
      hipFuncSetAttribute((const void*)k_mega, hipFuncAttributeMaxDynamicSharedMemorySize, LDS_BYTES);
      hipOccupancyMaxActiveBlocksPerMultiprocessor(&per_cu, (const void*)k_mega, 256, LDS_BYTES);
#endif
      if (per_cu < 1) per_cu = 1;
      if (per_cu > 2) per_cu = 2;
      grid_blocks = cus * per_cu;
      if (grid_blocks > 512) grid_blocks = 512;
      (void)hipGetLastError();
    }
  }
  if (state < 0) return;
  (void)MiB; (void)in_sizes;
  char* ws = (char*)d_ws;
  P p{};
  const float** f = (const float**)&p;
  for (int i = 0; i < 24; ++i) f[i] = (const float*)d_in[i];
  p.out = (float*)d_out;
  p.wT = (bf16_t*)(ws + o_wT);
  p.rope128 = (float2*)(ws + o_rope128); p.rope64 = (float2*)(ws + o_rope64);
  p.ssmA = (float4*)(ws + o_ssmA); p.ssmB = (float2*)(ws + o_ssmB); p.mod = (float*)(ws + o_mod); p.E = (float2*)(ws + o_E);
  p.XA = (float*)(ws + o_XA);
  p.sel = (unsigned short*)(ws + o_sel);
  p.scr = (unsigned*)(ws + o_scr);
  p.u_ssm = (bf16_t*)(ws + o_ussm); p.q = (bf16_t*)(ws + o_q); p.k = (bf16_t*)(ws + o_k); p.v = (bf16_t*)(ws + o_v);
  p.k8 = (unsigned char*)(ws + o_k); p.v8 = (unsigned char*)(ws + o_v);
  p.qidx = (bf16_t*)(ws + o_qidx); p.kidx = (bf16_t*)(ws + o_kidx); p.widx = (float*)(ws + o_widx);
  p.sg_s = (bf16_t*)(ws + o_sgs); p.sg_a = (bf16_t*)(ws + o_sga);
  p.y_pre = p.qidx;
  p.y_ssm = p.u_ssm;
  p.act = (bf16_t*)(ws + o_sel);
  p.u2 = p.sg_a;
#if MEGA
  void* args[] = {&p};
  hipError_t e = hipLaunchCooperativeKernel((const void*)k_mega, dim3(grid_blocks), dim3(256), args, LDS_BYTES, stream);
  if (e != hipSuccess) fprintf(stderr, "cooperative launch failed: %s (grid %d)\n", hipGetErrorString(e), grid_blocks);
#else
  const int G = 2048;
  launch_phase<PH_PRO>(p, 0, G, stream);
  for (int l = 0; l < 2; ++l) {
    launch_phase<PH_U1>(p, l, G, stream); launch_phase<PH_INPROJ>(p, l, G, stream); launch_phase<PH_SEL>(p, l, G, stream);
    launch_phase<PH_SSMA>(p, l, G, stream); launch_phase<PH_ATTN>(p, l, G, stream); launch_phase<PH_SSMB>(p, l, G, stream);
    launch_phase<PH_CHA>(p, l, G, stream); launch_phase<PH_CHB>(p, l, G, stream);
  }
#endif
}
```

```cpp
#include <hip/hip_runtime.h>
#include <hip/hip_cooperative_groups.h>
#include <cstdio>
#include <cstdint>
namespace cg = cooperative_groups;

#ifndef DIAG_PSEUDO
#define DIAG_PSEUDO 0
#endif
#ifndef DIAG_SCALE
#define DIAG_SCALE 0
#endif
#ifndef MEGA
#define MEGA 1
#endif

typedef unsigned short bf16_t;
typedef short bf16x8 __attribute__((ext_vector_type(8)));
typedef float f32x4 __attribute__((ext_vector_type(4)));
typedef float f32x16 __attribute__((ext_vector_type(16)));
typedef unsigned u32x4 __attribute__((ext_vector_type(4)));
#define DI __device__ __forceinline__

constexpr int SEQ = 8192, NB = 8, DM = 1024, NTOK = NB * SEQ;
constexpr int DINP = 4736;
constexpr int DFF = 2816;
constexpr float ALPHA = 1.41421356237f;
constexpr float IDX_SCALE = 0.04419417382415922f;
constexpr float ATT_SCALE = 0.08838834764831845f;
constexpr int LDS_BYTES = 77824;

constexpr size_t WO_IN = 0, WO_GLU = WO_IN + (size_t)4864 * 1024, WO_PSSM = WO_GLU + 512 * 512, WO_PATTN = WO_PSSM + 1024 * 512,
                 WO_OUT = WO_PATTN + 1024 * 1024, WO_GU = WO_OUT + 1024 * 1024, WO_DOWN = WO_GU + (size_t)5632 * 1024, WO_LAYER = WO_DOWN + (size_t)1024 * DFF;

struct P {
  const float *x, *c, *w_cond, *b_cond, *w_in, *lam_re, *lam_im, *log_dt, *b_re, *b_im, *c_re, *c_im, *d_skip, *w_glu, *b_glu, *p_ssm, *p_attn, *w_out,
      *ln1_g, *ln1_b, *w_gu, *w_down, *ln2_g, *ln2_b;
  float* out;
  bf16_t* wT;
  float2* rope128;
  float2* rope64;
  float4* ssmA;
  float2* ssmB;
  float* mod;
  float2* E;
  float* XA;
  bf16_t *u_ssm, *q, *k, *v, *qidx, *kidx;
  unsigned char *k8, *v8;
  float* widx;
  bf16_t *sg_s, *sg_a;
  unsigned short* sel;
  unsigned* scr;
  bf16_t *y_pre, *y_ssm, *act, *u2;
};

DI int TIDX() { int t = __builtin_amdgcn_workitem_id_x(); asm volatile("" : "+v"(t)); return t; }
DI float bf2f(bf16_t h) { return __uint_as_float(((unsigned)h) << 16); }
DI bf16_t f2bf(float x) { return __builtin_bit_cast(bf16_t, (__bf16)x); }
typedef __bf16 hwbf16x2 __attribute__((ext_vector_type(2)));
typedef float hwf32x2 __attribute__((ext_vector_type(2)));
DI unsigned pack2(float a, float b) { const hwf32x2 f = {a, b}; return __builtin_bit_cast(unsigned, __builtin_convertvector(f, hwbf16x2)); }
DI float sigm(float x) { return __builtin_amdgcn_rcpf(1.f + __expf(-x)); }
DI uint2 pack8_fp8(const float* v) {
  int w0 = 0, w1 = 0;
  w0 = __builtin_amdgcn_cvt_pk_fp8_f32(v[0], v[1], w0, false); w0 = __builtin_amdgcn_cvt_pk_fp8_f32(v[2], v[3], w0, true);
  w1 = __builtin_amdgcn_cvt_pk_fp8_f32(v[4], v[5], w1, false); w1 = __builtin_amdgcn_cvt_pk_fp8_f32(v[6], v[7], w1, true);
  uint2 r; r.x = (unsigned)w0; r.y = (unsigned)w1; return r;
}
typedef float f32x2_t __attribute__((ext_vector_type(2)));
DI void fp8x4_to_bf16x4(unsigned w, unsigned& lo, unsigned& hi) {
  const f32x2_t a = __builtin_amdgcn_cvt_pk_f32_fp8((int)w, false), b = __builtin_amdgcn_cvt_pk_f32_fp8((int)w, true);
  lo = (__float_as_uint(a.x) >> 16) | (__float_as_uint(a.y) & 0xffff0000u);
  hi = (__float_as_uint(b.x) >> 16) | (__float_as_uint(b.y) & 0xffff0000u);
}
DI uint4 pack8(const float* v) { uint4 r; r.x = pack2(v[0], v[1]); r.y = pack2(v[2], v[3]); r.z = pack2(v[4], v[5]); r.w = pack2(v[6], v[7]); return r; }

struct ALoadBf16 {
  const bf16_t* A; int lda;
  DI u32x4 load(int row, int k) const { return *(const u32x4*)(A + (size_t)row * lda + k); }
};
struct ALoadXMod {
  const float* x; const float* sc; const float* sh;
  DI u32x4 load(int row, int k) const {
    const int b = row >> 13;
    const float4* xp = (const float4*)(x + (size_t)row * 1024 + k);
    const float4* sp = (const float4*)(sc + b * 6144 + k);
    const float4* hp = (const float4*)(sh + b * 6144 + k);
    float4 x0 = xp[0], x1 = xp[1], s0 = sp[0], s1 = sp[1], h0 = hp[0], h1 = hp[1];
    u32x4 r;
    r.x = pack2(x0.x * (1.f + s0.x) + h0.x, x0.y * (1.f + s0.y) + h0.y);
    r.y = pack2(x0.z * (1.f + s0.z) + h0.z, x0.w * (1.f + s0.w) + h0.w);
    r.z = pack2(x1.x * (1.f + s1.x) + h1.x, x1.y * (1.f + s1.y) + h1.y);
    r.w = pack2(x1.z * (1.f + s1.z) + h1.z, x1.w * (1.f + s1.w) + h1.w);
    return r;
  }
};

constexpr int LDT = 72;
constexpr int LDC = 132;

template <class AL, class EPI>
DI void gemm_tile(const AL& al, const bf16_t* __restrict__ Bt, int K, int m0, int n0, char* smem, const EPI& epi) {
  bf16_t* As = (bf16_t*)smem;
  bf16_t* Bs = As + 128 * LDT;
  float* Cs = (float*)smem;
  const int tid = TIDX(), lane = tid & 63, wave = tid >> 6, wm = wave >> 1, wn = wave & 1;
  const int lr = lane & 31, lh = lane >> 5;
  f32x16 acc[2][2];
#pragma unroll
  for (int i = 0; i < 2; ++i)
#pragma unroll
    for (int j = 0; j < 2; ++j)
#pragma unroll
      for (int r = 0; r < 16; ++r) acc[i][j][r] = 0.f;
  u32x4 ra[4], rb[4];
  const int nkt = K >> 6;
#pragma unroll
  for (int i = 0; i < 4; ++i) {
    const int c = tid + 256 * i, row = c >> 3, kc = (c & 7) * 8;
    ra[i] = al.load(m0 + row, kc);
    rb[i] = *(const u32x4*)(Bt + (size_t)(n0 + row) * K + kc);
  }
  for (int kt = 0; kt < nkt; ++kt) {
    __syncthreads();
#pragma unroll
    for (int i = 0; i < 4; ++i) {
      const int c = tid + 256 * i, row = c >> 3, kc = (c & 7) * 8;
      *(u32x4*)(As + row * LDT + kc) = ra[i];
      *(u32x4*)(Bs + row * LDT + kc) = rb[i];
    }
    __syncthreads();
    if (kt + 1 < nkt) {
      const int k0 = (kt + 1) << 6;
#pragma unroll
      for (int i = 0; i < 4; ++i) {
        const int c = tid + 256 * i, row = c >> 3, kc = (c & 7) * 8;
        ra[i] = al.load(m0 + row, k0 + kc);
        rb[i] = *(const u32x4*)(Bt + (size_t)(n0 + row) * K + k0 + kc);
      }
    }
#pragma unroll
    for (int ks = 0; ks < 4; ++ks) {
      bf16x8 a[2], b[2];
#pragma unroll
      for (int i = 0; i < 2; ++i) a[i] = *(const bf16x8*)(As + (wm * 64 + i * 32 + lr) * LDT + ks * 16 + lh * 8);
#pragma unroll
      for (int j = 0; j < 2; ++j) b[j] = *(const bf16x8*)(Bs + (wn * 64 + j * 32 + lr) * LDT + ks * 16 + lh * 8);
#pragma unroll
      for (int i = 0; i < 2; ++i)
#pragma unroll
        for (int j = 0; j < 2; ++j) acc[i][j] = __builtin_amdgcn_mfma_f32_32x32x16_bf16(a[i], b[j], acc[i][j], 0, 0, 0);
    }
  }
  __syncthreads();
#pragma unroll
  for (int i = 0; i < 2; ++i)
#pragma unroll
    for (int j = 0; j < 2; ++j)
#pragma unroll
      for (int r = 0; r < 16; ++r) {
        const int row = wm * 64 + i * 32 + (r & 3) + 8 * (r >> 2) + 4 * lh, col = wn * 64 + j * 32 + lr;
        Cs[row * LDC + col] = acc[i][j][r];
      }
  __syncthreads();
  epi(Cs, m0, n0);
}


template <class AL, class EPI>
DI void gemm_wide(const AL& al, const bf16_t* __restrict__ Bt, int K, int m0, int n0, int nhalf, char* smem, const EPI& epi) {
  bf16_t* As = (bf16_t*)smem;
  bf16_t* Bs = As + 128 * LDT;
  float* Cs = (float*)smem;
  const int tid = TIDX(), lane = tid & 63, wave = tid >> 6, wm = wave >> 1, wn = wave & 1;
  const int lr = lane & 31, lh = lane >> 5;
  f32x16 acc[2][4];
#pragma unroll
  for (int i = 0; i < 2; ++i)
#pragma unroll
    for (int j = 0; j < 4; ++j)
#pragma unroll
      for (int r = 0; r < 16; ++r) acc[i][j][r] = 0.f;
  u32x4 ra[4], rb[8];
  const int nkt = K >> 6;
#pragma unroll
  for (int i = 0; i < 8; ++i) {
    const int c = tid + 256 * i, row = c >> 3, kc = (c & 7) * 8;
    if (i < 4) ra[i] = al.load(m0 + row, kc);
    rb[i] = *(const u32x4*)(Bt + (size_t)(n0 + row) * K + kc);
  }
#pragma unroll 1
  for (int kt = 0; kt < nkt; ++kt) {
    __syncthreads();
#pragma unroll
    for (int i = 0; i < 8; ++i) {
      const int c = tid + 256 * i, row = c >> 3, kc = (c & 7) * 8;
      if (i < 4) *(u32x4*)(As + row * LDT + kc) = ra[i];
      *(u32x4*)(Bs + row * LDT + kc) = rb[i];
    }
    __syncthreads();
    if (kt + 1 < nkt) {
      const int k0 = (kt + 1) << 6;
#pragma unroll
      for (int i = 0; i < 8; ++i) {
        const int c = tid + 256 * i, row = c >> 3, kc = (c & 7) * 8;
        if (i < 4) ra[i] = al.load(m0 + row, k0 + kc);
        rb[i] = *(const u32x4*)(Bt + (size_t)(n0 + row) * K + k0 + kc);
      }
    }
    {
      bf16x8 a[2][2], b[2][4];
#pragma unroll
      for (int i = 0; i < 2; ++i) a[0][i] = *(const bf16x8*)(As + (wm * 64 + i * 32 + lr) * LDT + lh * 8);
#pragma unroll
      for (int j = 0; j < 4; ++j) b[0][j] = *(const bf16x8*)(Bs + (wn * 128 + j * 32 + lr) * LDT + lh * 8);
#pragma unroll
      for (int ks = 0; ks < 4; ++ks) {
        if (ks + 1 < 4) {
#pragma unroll
          for (int i = 0; i < 2; ++i) a[(ks + 1) & 1][i] = *(const bf16x8*)(As + (wm * 64 + i * 32 + lr) * LDT + (ks + 1) * 16 + lh * 8);
#pragma unroll
          for (int j = 0; j < 4; ++j) b[(ks + 1) & 1][j] = *(const bf16x8*)(Bs + (wn * 128 + j * 32 + lr) * LDT + (ks + 1) * 16 + lh * 8);
        }
#pragma unroll
        for (int i = 0; i < 2; ++i)
#pragma unroll
          for (int j = 0; j < 4; ++j) acc[i][j] = __builtin_amdgcn_mfma_f32_32x32x16_bf16(a[ks & 1][i], b[ks & 1][j], acc[i][j], 0, 0, 0);
        if (ks + 1 < 4) {
#pragma unroll
          for (int g = 0; g < 6; ++g) {
            __builtin_amdgcn_sched_group_barrier(0x100, 1, 0);
            __builtin_amdgcn_sched_group_barrier(0x008, 1, 0);
          }
          __builtin_amdgcn_sched_group_barrier(0x008, 2, 0);
        } else {
          __builtin_amdgcn_sched_group_barrier(0x008, 8, 0);
        }
      }
    }
  }
#pragma unroll
  for (int half = 0; half < 2; ++half) {
    __syncthreads();
    if (wn == half) {
#pragma unroll
      for (int i = 0; i < 2; ++i)
#pragma unroll
        for (int j = 0; j < 4; ++j)
#pragma unroll
          for (int r = 0; r < 16; ++r) {
            const int row = wm * 64 + i * 32 + (r & 3) + 8 * (r >> 2) + 4 * lh, col = j * 32 + lr;
            Cs[row * LDC + col] = acc[i][j][r];
          }
    }
    __syncthreads();
    if (half < nhalf) epi(Cs, m0, n0 + 128 * half);
  }
}

struct EpiInproj {
  const P& p;
  DI void operator()(const float* Cs, int m0, int n0) const {
    const int nt = n0 >> 7, tid = TIDX();
#pragma unroll 1
    for (int pass = 0; pass < 8; ++pass) {
      const int row = pass * 16 + (tid >> 4), c8 = (tid & 15) * 8;
      const size_t tok = (size_t)(m0 + row);
      const int pos = (int)(tok & 8191);
      const float* cr = Cs + row * LDC;
      float v[8];
      if (nt < 4) {
#pragma unroll
        for (int e = 0; e < 8; ++e) v[e] = cr[c8 + e];
        *(uint4*)(p.u_ssm + tok * 512 + nt * 128 + c8) = pack8(v);
      } else if (nt < 14) {
        const float2* rt = p.rope128 + pos * 64;
        if (c8 < 64) {
#pragma unroll
          for (int e = 0; e < 8; ++e) { const int c = c8 + e; const float2 cs = rt[c]; v[e] = cr[c] * cs.x - cr[c + 64] * cs.y; }
        } else {
#pragma unroll
          for (int e = 0; e < 8; ++e) { const int c = c8 + e, cc = c - 64; const float2 cs = rt[cc]; v[e] = cr[c] * cs.x + cr[cc] * cs.y; }
        }
        if (nt < 12) *(uint4*)(p.q + tok * 1024 + (nt - 4) * 128 + c8) = pack8(v);
        else *(uint2*)(p.k8 + tok * 256 + (nt - 12) * 128 + c8) = pack8_fp8(v);
      } else if (nt < 16) {
#pragma unroll
        for (int e = 0; e < 8; ++e) v[e] = cr[c8 + e];
        *(uint2*)(p.v8 + tok * 256 + (nt - 14) * 128 + c8) = pack8_fp8(v);
      } else if (nt < 20 || (nt == 20 && c8 < 64)) {
        const float2* rt = p.rope64 + pos * 32;
        const int cl = c8 & 63;
        if (cl < 32) {
#pragma unroll
          for (int e = 0; e < 8; ++e) { const int c = c8 + e; const float2 cs = rt[cl + e]; v[e] = cr[c] * cs.x - cr[c + 32] * cs.y; }
        } else {
#pragma unroll
          for (int e = 0; e < 8; ++e) { const int c = c8 + e; const float2 cs = rt[cl + e - 32]; v[e] = cr[c] * cs.x + cr[c - 32] * cs.y; }
        }
        bf16_t* dst = (nt < 20) ? (p.qidx + tok * 512 + (nt - 16) * 128 + c8) : (p.kidx + tok * 64 + c8);
        *(uint4*)dst = pack8(v);
      } else if (nt == 20) {
        if (c8 == 64) {
          float4 w0, w1;
          w0.x = cr[64] * IDX_SCALE; w0.y = cr[65] * IDX_SCALE; w0.z = cr[66] * IDX_SCALE; w0.w = cr[67] * IDX_SCALE;
          w1.x = cr[68] * IDX_SCALE; w1.y = cr[69] * IDX_SCALE; w1.z = cr[70] * IDX_SCALE; w1.w = cr[71] * IDX_SCALE;
          *(float4*)(p.widx + tok * 8) = w0; *(float4*)(p.widx + tok * 8 + 4) = w1;
        }
      } else {
#pragma unroll
        for (int e = 0; e < 8; ++e) v[e] = sigm(cr[c8 + e]);
        bf16_t* dst = (nt < 29) ? (p.sg_s + tok * 1024 + (nt - 21) * 128 + c8) : (p.sg_a + tok * 1024 + (nt - 29) * 128 + c8);
        *(uint4*)dst = pack8(v);
      }
    }
  }
};

struct EpiGlu {
  const P& p; const float* bglu;
  DI void operator()(const float* Cs, int m0, int n0) const {
    const int tid = TIDX(), c8 = (tid & 15) * 8, r0 = tid >> 4;
    u32x4 yr[8];
#pragma unroll
    for (int pass = 0; pass < 8; ++pass) yr[pass] = *(const u32x4*)(p.y_pre + (size_t)(m0 + pass * 16 + r0) * 512 + n0 + c8);
    float bg[8];
#pragma unroll
    for (int e = 0; e < 8; ++e) bg[e] = bglu[n0 + c8 + e];
#pragma unroll
    for (int pass = 0; pass < 8; ++pass) {
      const int row = pass * 16 + r0;
      const float* cr = Cs + row * LDC + c8;
      float v[8];
#pragma unroll
      for (int e = 0; e < 8; ++e) {
        const unsigned w = yr[pass][e >> 1];
        const float y = __uint_as_float((e & 1) ? (w & 0xffff0000u) : (w << 16));
        v[e] = y * sigm(cr[e] + bg[e]);
      }
      *(uint4*)(p.y_ssm + (size_t)(m0 + row) * 512 + n0 + c8) = pack8(v);
    }
  }
};

struct EpiMerge1 {
  const P& p;
  DI void operator()(const float* Cs, int m0, int n0) const {
    const int tid = TIDX(), c8 = (tid & 15) * 8, r0 = tid >> 4;
    u32x4 gr[8];
#pragma unroll
    for (int pass = 0; pass < 8; ++pass) gr[pass] = *(const u32x4*)(p.sg_s + (size_t)(m0 + pass * 16 + r0) * 1024 + n0 + c8);
#pragma unroll
    for (int pass = 0; pass < 8; ++pass) {
      const int row = pass * 16 + r0;
      const float* cr = Cs + row * LDC + c8;
      float v[8];
#pragma unroll
      for (int e = 0; e < 8; ++e) {
        const unsigned w = gr[pass][e >> 1];
        const float g = __uint_as_float((e & 1) ? (w & 0xffff0000u) : (w << 16));
        v[e] = g * cr[e];
      }
      *(uint4*)(p.sg_s + (size_t)(m0 + row) * 1024 + n0 + c8) = pack8(v);
    }
  }
};
struct EpiMerge2 {
  const P& p;
  DI void operator()(const float* Cs, int m0, int n0) const {
    const int tid = TIDX(), c8 = (tid & 15) * 8, r0 = tid >> 4;
    u32x4 gr[8], pr[8];
#pragma unroll
    for (int pass = 0; pass < 8; ++pass) {
      gr[pass] = *(const u32x4*)(p.sg_a + (size_t)(m0 + pass * 16 + r0) * 1024 + n0 + c8);
      pr[pass] = *(const u32x4*)(p.sg_s + (size_t)(m0 + pass * 16 + r0) * 1024 + n0 + c8);
    }
#pragma unroll
    for (int pass = 0; pass < 8; ++pass) {
      const int row = pass * 16 + r0;
      const float* cr = Cs + row * LDC + c8;
      float v[8];
#pragma unroll
      for (int e = 0; e < 8; ++e) {
        const unsigned wg = gr[pass][e >> 1], wp = pr[pass][e >> 1];
        const float g = __uint_as_float((e & 1) ? (wg & 0xffff0000u) : (wg << 16));
        const float pa = __uint_as_float((e & 1) ? (wp & 0xffff0000u) : (wp << 16));
        v[e] = pa + g * cr[e];
      }
      *(uint4*)(p.sg_s + (size_t)(m0 + row) * 1024 + n0 + c8) = pack8(v);
    }
  }
};
struct EpiResid {
  const float* xin; const float* gt; float* dst;
  DI void operator()(const float* Cs, int m0, int n0) const {
    const int tid = TIDX(), c8 = (tid & 15) * 8, r0 = tid >> 4;
    const int b = m0 >> 13;
    f32x4 xa[8], xb[8];
#pragma unroll
    for (int pass = 0; pass < 8; ++pass) {
      const f32x4* xs = (const f32x4*)(xin + (size_t)(m0 + pass * 16 + r0) * 1024 + n0 + c8);
      xa[pass] = xs[0]; xb[pass] = xs[1];
    }
    const f32x4* gs = (const f32x4*)(gt + b * 6144 + n0 + c8);
    const f32x4 g0 = gs[0], g1 = gs[1];
#pragma unroll
    for (int pass = 0; pass < 8; ++pass) {
      const int row = pass * 16 + r0;
      const float* cr = Cs + row * LDC + c8;
      f32x4 o0, o1;
#pragma unroll
      for (int e = 0; e < 4; ++e) { o0[e] = ALPHA * xa[pass][e] + (1.f + g0[e]) * cr[e]; o1[e] = ALPHA * xb[pass][e] + (1.f + g1[e]) * cr[4 + e]; }
      f32x4* d = (f32x4*)(dst + (size_t)(m0 + row) * 1024 + n0 + c8);
      d[0] = o0; d[1] = o1;
    }
  }
};
struct EpiGateUp {
  const P& p;
  DI void operator()(const float* Cs, int m0, int n0) const {
    const int tid = TIDX(), j = n0 >> 7;
#pragma unroll 1
    for (int pass = 0; pass < 4; ++pass) {
      const int row = pass * 32 + (tid >> 3), c8 = (tid & 7) * 8;
      const size_t tok = (size_t)(m0 + row);
      const float* cr = Cs + row * LDC + c8;
      float v[8];
#pragma unroll
      for (int e = 0; e < 8; ++e) { const float a = cr[e], bb = cr[64 + e]; v[e] = a * sigm(a) * bb; }
      *(uint4*)(p.act + tok * DFF + j * 64 + c8) = pack8(v);
    }
  }
};

DI int colmap(int mode, int n) {
  if (mode == 0) return n;
  if (mode == 1) return n < 2632 ? n : (n < 2688 ? -1 : (n < 4736 ? n - 56 : -1));
  const int j = n >> 7, r = n & 127;
  return r < 64 ? (64 * j + r) : (2816 + 64 * j + (r - 64));
}
DI void transpose_item(const float* __restrict__ src, int K, int Ns, bf16_t* __restrict__ dst, int mode, int item, char* smem) {
  float* T = (float*)smem;
  const int nkt = K >> 6, kt = item % nkt, nt = item / nkt, k0 = kt * 64, n0 = nt * 64, tid = TIDX();
  __syncthreads();
  {
    const int n = n0 + (tid & 63), sc = colmap(mode, n);
#pragma unroll 4
    for (int rr = 0; rr < 16; ++rr) {
      const int r = rr * 4 + (tid >> 6);
      T[r * 65 + (tid & 63)] = sc >= 0 ? src[(size_t)(k0 + r) * Ns + sc] : 0.f;
    }
  }
  __syncthreads();
#pragma unroll 4
  for (int rr = 0; rr < 16; ++rr) {
    const int nn = rr * 4 + (tid >> 6);
    dst[(size_t)(n0 + nn) * K + k0 + (tid & 63)] = f2bf(T[(tid & 63) * 65 + nn]);
  }
}

constexpr int TR_IN = 76 * 16, TR_GLU = 64, TR_PSSM = 16 * 8, TR_PATTN = 256, TR_OUT = 256, TR_GU = 88 * 16, TR_DOWN = 16 * 44;
constexpr int TR_LAYER = TR_IN + TR_GLU + TR_PSSM + TR_PATTN + TR_OUT + TR_GU + TR_DOWN;
constexpr int N_TR = 2 * TR_LAYER, N_COND = 2 * 192, N_ROPE = 8192 / 8, N_SSMT = (2 * 32 * 64) / 256;
constexpr int N_PRO = N_TR + N_COND + N_ROPE + N_SSMT;

DI void prologue_item(const P& p, int item, char* smem) {
  const int tid = TIDX();
  if (item < N_TR) {
    const int l = item / TR_LAYER; int it = item % TR_LAYER;
    bf16_t* wl = p.wT + (size_t)l * WO_LAYER;
    if (it < TR_IN) { transpose_item(p.w_in + (size_t)l * 1024 * 4680, 1024, 4680, wl + WO_IN, 1, it, smem); return; } it -= TR_IN;
    if (it < TR_GLU) { transpose_item(p.w_glu + (size_t)l * 512 * 512, 512, 512, wl + WO_GLU, 0, it, smem); return; } it -= TR_GLU;
    if (it < TR_PSSM) { transpose_item(p.p_ssm + (size_t)l * 512 * 1024, 512, 1024, wl + WO_PSSM, 0, it, smem); return; } it -= TR_PSSM;
    if (it < TR_PATTN) { transpose_item(p.p_attn + (size_t)l * 1024 * 1024, 1024, 1024, wl + WO_PATTN, 0, it, smem); return; } it -= TR_PATTN;
    if (it < TR_OUT) { transpose_item(p.w_out + (size_t)l * 1024 * 1024, 1024, 1024, wl + WO_OUT, 0, it, smem); return; } it -= TR_OUT;
    if (it < TR_GU) { transpose_item(p.w_gu + (size_t)l * 1024 * 5632, 1024, 5632, wl + WO_GU, 2, it, smem); return; } it -= TR_GU;
    transpose_item(p.w_down + (size_t)l * DFF * 1024, DFF, 1024, wl + WO_DOWN, 0, it, smem); return;
  }
  item -= N_TR;
  if (item < N_COND) {
    const int l = item / 192, n0 = (item % 192) * 32;
    float* sc = (float*)smem;
    float* red = sc + 8192;
    __syncthreads();
    for (int i = tid; i < 8192; i += 256) { const float cv = p.c[i]; sc[i] = cv * sigm(cv); }
    __syncthreads();
    const int nn = tid & 31, kc = tid >> 5;
    float acc[8];
#pragma unroll
    for (int b = 0; b < 8; ++b) acc[b] = 0.f;
    const float* wp = p.w_cond + ((size_t)l * 1024 + kc * 128) * 6144 + n0 + nn;
    for (int k = 0; k < 128; ++k) {
      const float w = wp[(size_t)k * 6144];
#pragma unroll
      for (int b = 0; b < 8; ++b) acc[b] += sc[b * 1024 + kc * 128 + k] * w;
    }
#pragma unroll
    for (int b = 0; b < 8; ++b) red[(kc * 8 + b) * 32 + nn] = acc[b];
    __syncthreads();
    {
      const int b = tid >> 5;
      float s = 0.f;
#pragma unroll
      for (int q = 0; q < 8; ++q) s += red[(q * 8 + b) * 32 + nn];
      p.mod[((size_t)l * 8 + b) * 6144 + n0 + nn] = s + p.b_cond[l * 6144 + n0 + nn];
    }
    return;
  }
  item -= N_COND;
  if (item < N_ROPE) {
#pragma unroll 1
    for (int k = 0; k < 3; ++k) {
      const int e = tid + 256 * k;
      const int pos = item * 8 + e / 96, j = e % 96;
      if (j < 64) {
        const float inv = (float)pow(10000.0, -(double)j / 64.0);
        const float ang = (float)pos * inv;
        p.rope128[pos * 64 + j] = make_float2((float)cos((double)ang), (float)sin((double)ang));
      } else {
        const int i = j - 64;
        const float inv = (float)pow(10000.0, -(double)i / 32.0);
        const float ang = (float)pos * inv;
        p.rope64[pos * 32 + i] = make_float2((float)cos((double)ang), (float)sin((double)ang));
      }
    }
    return;
  }
  item -= N_ROPE;
  {
    const int idx = item * 256 + tid;
    const int lg = idx >> 6;
    const double dt = exp((double)p.log_dt[lg]);
    const double lr = p.lam_re[idx], li = p.lam_im[idx];
    const double mag = exp(lr * dt), ar = mag * cos(li * dt), ai = mag * sin(li * dt);
    const double mag128 = exp(lr * dt * 128.0), ar128 = mag128 * cos(li * dt * 128.0), ai128 = mag128 * sin(li * dt * 128.0);
    const double den = lr * lr + li * li, nr = ar - 1.0;
    const double fr = (nr * lr + ai * li) / den, fi = (ai * lr - nr * li) / den;
    p.ssmA[idx] = make_float4((float)ar, (float)ai, (float)ar128, (float)ai128);
    for (int i = 0; i < 16; ++i) {
      const double br = p.b_re[(size_t)idx * 16 + i], bi = p.b_im[(size_t)idx * 16 + i];
      p.ssmB[(size_t)idx * 16 + i] = make_float2((float)(fr * br - fi * bi), (float)(fr * bi + fi * br));
    }
  }
}

template <bool FULL>
DI void ssm_item(const P& p, int l, int item, char* smem) {
  const int tid = TIDX(), lane = tid & 63, wave = tid >> 6;
  const int b = item >> 9, c = (item >> 3) & 63, g = (item & 7) * 4 + wave;
  float* H = (float*)smem + wave * (16 * 132 + 256);
  float* us = H + 16 * 132;
  const int lg = l * 32 + g;
  const float4 a4 = p.ssmA[lg * 64 + lane];
  const float ar = a4.x, ai = a4.y;
  float bbr[16], bbi[16];
  {
    const float4* bp = (const float4*)(p.ssmB + ((size_t)lg * 64 + lane) * 16);
#pragma unroll
    for (int i = 0; i < 8; ++i) { const float4 t = bp[i]; bbr[2 * i] = t.x; bbi[2 * i] = t.y; bbr[2 * i + 1] = t.z; bbi[2 * i + 1] = t.w; }
  }
  float hr = 0.f, hi = 0.f;
  const int ch = lane & 15, quad = lane >> 4;
  float creg[32];
  float dsk = 0.f;
  if (FULL) {
    const float2* Ep = p.E + ((size_t)(b * 32 + g) * 64) * 64 + lane;
    for (int cc = 0; cc < c; ++cc) {
      const float2 e = Ep[cc * 64];
      const float nhr = a4.z * hr - a4.w * hi + e.x, nhi = a4.z * hi + a4.w * hr + e.y;
      hr = nhr; hi = nhi;
    }
    const float* cp = (quad < 2 ? p.c_re : p.c_im) + ((size_t)lg * 16 + ch) * 64 + (quad & 1) * 32;
    const float sgn = quad < 2 ? 1.f : -1.f;
#pragma unroll
    for (int i = 0; i < 8; ++i) { const float4 t = ((const float4*)cp)[i]; creg[4 * i] = sgn * t.x; creg[4 * i + 1] = sgn * t.y; creg[4 * i + 2] = sgn * t.z; creg[4 * i + 3] = sgn * t.w; }
    dsk = p.d_skip[l * 512 + g * 16 + ch];
  }
  const size_t tok0 = (size_t)b * SEQ + c * 128;
#pragma unroll 1
  for (int s = 0; s < 8; ++s) {
    const int tt = lane >> 2, part = lane & 3;
    const uint2 raw = *(const uint2*)(p.u_ssm + (tok0 + s * 16 + tt) * 512 + g * 16 + part * 4);
    float4 uf;
    uf.x = __uint_as_float(raw.x << 16); uf.y = __uint_as_float(raw.x & 0xffff0000u);
    uf.z = __uint_as_float(raw.y << 16); uf.w = __uint_as_float(raw.y & 0xffff0000u);
    __builtin_amdgcn_wave_barrier();
    *(float4*)(us + tt * 16 + part * 4) = uf;
    __builtin_amdgcn_wave_barrier();
#pragma unroll 4
    for (int t = 0; t < 16; ++t) {
      const float4* up = (const float4*)(us + t * 16);
      const float4 u0 = up[0], u1 = up[1], u2 = up[2], u3 = up[3];
      const float uu[16] = {u0.x, u0.y, u0.z, u0.w, u1.x, u1.y, u1.z, u1.w, u2.x, u2.y, u2.z, u2.w, u3.x, u3.y, u3.z, u3.w};
      float br = 0.f, bi = 0.f;
#pragma unroll
      for (int i = 0; i < 16; ++i) { br = fmaf(bbr[i], uu[i], br); bi = fmaf(bbi[i], uu[i], bi); }
      const float nhr = ar * hr - ai * hi + br, nhi = ar * hi + ai * hr + bi;
      hr = nhr; hi = nhi;
      if (FULL) { H[t * 132 + lane] = hr; H[t * 132 + 64 + lane] = hi; }
    }
    if (FULL) {
      __builtin_amdgcn_wave_barrier();
      f32x4 acc = {0.f, 0.f, 0.f, 0.f};
      const float* hp = H + ch * 132 + quad * 32;
#pragma unroll
      for (int i = 0; i < 8; ++i) {
        const float4 hv = *(const float4*)(hp + 4 * i);
        acc = __builtin_amdgcn_mfma_f32_16x16x4f32(hv.x, creg[4 * i], acc, 0, 0, 0);
        acc = __builtin_amdgcn_mfma_f32_16x16x4f32(hv.y, creg[4 * i + 1], acc, 0, 0, 0);
        acc = __builtin_amdgcn_mfma_f32_16x16x4f32(hv.z, creg[4 * i + 2], acc, 0, 0, 0);
        acc = __builtin_amdgcn_mfma_f32_16x16x4f32(hv.w, creg[4 * i + 3], acc, 0, 0, 0);
      }
#pragma unroll
      for (int r = 0; r < 4; ++r) {
        const int tl = quad * 4 + r;
        float y = acc[r] + dsk * us[tl * 16 + ch];
        const float y3 = y * y * y;
        y = y * sigm(1.5957691216057308f * (y + 0.044715f * y3));
        p.y_pre[(tok0 + s * 16 + tl) * 512 + g * 16 + ch] = f2bf(y);
      }
    }
  }
  if (!FULL) p.E[((size_t)(b * 32 + g) * 64 + c) * 64 + lane] = make_float2(hr, hi);
}

DI unsigned mono(float f) { const unsigned u = __float_as_uint(f); return (u & 0x80000000u) ? ~u : (u | 0x80000000u); }

DI void select_item(const P& p, int b, int quad4, int bid, char* smem) {
  const int t0 = quad4 * 4;
  if (t0 < 256) return;
  const int tid = TIDX(), lane = tid & 63, wave = tid >> 6;
  unsigned* hist = (unsigned*)smem + wave * 256;
  unsigned* candi = (unsigned*)smem + 1024 + wave * 512;
  unsigned* candk = candi + 256;
  unsigned short* sc16 = (unsigned short*)((unsigned*)smem + 3072);
  unsigned* scr = p.scr + (size_t)bid * 4 * 8192;
  const size_t tok0 = (size_t)b * SEQ + t0;
  __syncthreads();
  {
    const int r = lane & 31, h = lane >> 5;
    bf16x8 a[4];
    {
      const bf16_t* qp = p.qidx + (tok0 + (r >> 3)) * 512 + (r & 7) * 64 + h * 8;
#pragma unroll
      for (int s = 0; s < 4; ++s) a[s] = *(const bf16x8*)(qp + s * 16);
    }
    float4 w[4];
#pragma unroll
    for (int q = 0; q < 4; ++q) w[q] = *(const float4*)(p.widx + (tok0 + q) * 8 + h * 4);
    const int ntile = (t0 + 4 + 31) >> 5;
    const bf16_t* kbase = p.kidx + ((size_t)b * SEQ) * 64 + h * 8;
    const int nit = (ntile - wave + 3) >> 2;
#pragma unroll 1
    for (int i0 = 0; i0 < nit; i0 += 4) {
      bf16x8 bf[4][4];
#pragma unroll
      for (int u = 0; u < 4; ++u) {
        int kt = wave + 4 * (i0 + u); kt = kt < ntile ? kt : ntile - 1;
        const bf16_t* kp = kbase + (size_t)(kt * 32 + r) * 64;
#pragma unroll
        for (int s = 0; s < 4; ++s) bf[u][s] = *(const bf16x8*)(kp + s * 16);
      }
#pragma unroll
      for (int u = 0; u < 4; ++u) {
        const int key = (wave + 4 * (i0 + u)) * 32 + r;
        f32x16 acc;
#pragma unroll
        for (int i = 0; i < 16; ++i) acc[i] = 0.f;
#pragma unroll
        for (int s = 0; s < 4; ++s) acc = __builtin_amdgcn_mfma_f32_32x32x16_bf16(a[s], bf[u][s], acc, 0, 0, 0);
        float tot[4];
#pragma unroll
        for (int q = 0; q < 4; ++q) {
          float sq = 0.f;
          sq = fmaf(fmaxf(acc[4 * q + 0], 0.f), w[q].x, sq); sq = fmaf(fmaxf(acc[4 * q + 1], 0.f), w[q].y, sq);
          sq = fmaf(fmaxf(acc[4 * q + 2], 0.f), w[q].z, sq); sq = fmaf(fmaxf(acc[4 * q + 3], 0.f), w[q].w, sq);
          tot[q] = sq + __shfl_xor(sq, 32);
        }
        if (i0 + u < nit) {
          const unsigned m0 = mono(h == 0 ? tot[0] : tot[2]), m1 = mono(h == 0 ? tot[1] : tot[3]);
          const int q0 = h * 2;
          sc16[q0 * 8192 + key] = (unsigned short)(m0 >> 16); sc16[(q0 + 1) * 8192 + key] = (unsigned short)(m1 >> 16);
          __builtin_nontemporal_store(m0, scr + q0 * 8192 + key); __builtin_nontemporal_store(m1, scr + (q0 + 1) * 8192 + key);
        }
      }
    }
  }
  __syncthreads();
  {
    const int qi = wave, n = t0 + qi + 1;
    const unsigned short* s = sc16 + qi * 8192;
    const unsigned* s32 = (const unsigned*)s;
    unsigned prefix = 0, pmask = 0, need = 256, eq_total = 0;
#pragma unroll 1
    for (int pass = 0; pass < 2; ++pass) {
      const int shift = 8 - 8 * pass;
#pragma unroll
      for (int k = 0; k < 4; ++k) hist[lane + 64 * k] = 0;
      __builtin_amdgcn_wave_barrier();
      for (int e2 = lane; 2 * e2 < n; e2 += 64) {
        const unsigned wv = s32[e2];
        const unsigned k0 = wv & 0xffffu, k1 = wv >> 16;
        if ((k0 & pmask) == prefix) atomicAdd(&hist[(k0 >> shift) & 255], 1u);
        if (2 * e2 + 1 < n && (k1 & pmask) == prefix) atomicAdd(&hist[(k1 >> shift) & 255], 1u);
      }
      __builtin_amdgcn_wave_barrier();
      const uint4 h4 = *(const uint4*)(hist + 4 * lane);
      const unsigned sum = h4.x + h4.y + h4.z + h4.w;
      unsigned incl = sum;
#pragma unroll
      for (int off = 1; off < 64; off <<= 1) { const unsigned v = __shfl_down(incl, off); if (lane + off < 64) incl += v; }
      unsigned above = incl - sum;
      const bool found = above < need && need <= incl;
      unsigned dig = 0, cnt = 0;
      if (found) {
        if (above + h4.w >= need) { dig = 3; cnt = h4.w; }
        else { above += h4.w;
          if (above + h4.z >= need) { dig = 2; cnt = h4.z; }
          else { above += h4.z;
            if (above + h4.y >= need) { dig = 1; cnt = h4.y; }
            else { above += h4.y; dig = 0; cnt = h4.x; } } }
        dig += 4 * lane;
      }
      const unsigned long long fb = __ballot(found);
      const int fl = fb ? (__ffsll((long long)fb) - 1) : 0;
      const unsigned dsel = __shfl(dig, fl), nneed = __shfl(need - above, fl), ncnt = __shfl(cnt, fl);
      prefix |= dsel << shift; pmask |= 0xffu << shift; need = nneed; eq_total = ncnt;
      __builtin_amdgcn_wave_barrier();
    }
    const unsigned thr = prefix, ngt = 256 - need;
    unsigned short* dst = p.sel + (tok0 + qi) * 256;
    const unsigned long long lm = (1ull << lane) - 1ull;
    unsigned og = 0, oe = 0;
    for (int base = 0; base < n; base += 64) {
      const int e = base + lane;
      const unsigned u = e < n ? (unsigned)s[e] : 0u;
      const bool isg = e < n && u > thr, ise = e < n && u == thr;
      const unsigned long long bg = __ballot(isg), be = __ballot(ise);
      if (isg) { const unsigned pos = og + __popcll(bg & lm); if (pos < 256u) dst[pos] = (unsigned short)e; }
      if (ise) { const unsigned rr = oe + __popcll(be & lm); if (rr < 256u) candi[rr] = (unsigned)e; }
      og += __popcll(bg); oe += __popcll(be);
    }
    __builtin_amdgcn_wave_barrier();
    const unsigned c = eq_total < 256u ? eq_total : 256u;
    if (eq_total == need) {
      for (unsigned i = lane; i < c; i += 64) if (ngt + i < 256u) dst[ngt + i] = (unsigned short)candi[i];
    } else {
      for (unsigned i = lane; i < c; i += 64) candk[i] = __hip_atomic_load(scr + qi * 8192 + candi[i], __ATOMIC_RELAXED, __HIP_MEMORY_SCOPE_AGENT);
      __builtin_amdgcn_wave_barrier();
      for (unsigned i = lane; i < c; i += 64) {
        const unsigned ki = candk[i];
        unsigned rank = 0;
        for (unsigned j2 = 0; j2 < c; ++j2) { const unsigned kj = candk[j2]; rank += (kj > ki || (kj == ki && j2 < i)) ? 1u : 0u; }
        if (rank < need && ngt + rank < 256u) dst[ngt + rank] = (unsigned short)candi[i];
      }
    }
  }
  __syncthreads();
}

DI void attn_item(const P& p, int b, int kvh, int quad4, char* smem) {
  const int tid = TIDX(), lane = tid & 63, wave = tid >> 6;
  const int t = quad4 * 4 + wave;
  const size_t tok = (size_t)b * SEQ + t;
  float* L = (float*)smem + wave * (1024 + 256);
  int* idx = (int*)(L + 1024);
  const int cnt = t < 256 ? t + 1 : 256;
  __builtin_amdgcn_wave_barrier();
  if (t < 256) {
#pragma unroll
    for (int j = 0; j < 4; ++j) { const int n = lane + 64 * j; idx[n] = n < cnt ? n : 0; }
  } else {
    const uint2 sv = *(const uint2*)(p.sel + tok * 256 + lane * 4);
    idx[lane * 4 + 0] = sv.x & 0xffff; idx[lane * 4 + 1] = sv.x >> 16; idx[lane * 4 + 2] = sv.y & 0xffff; idx[lane * 4 + 3] = sv.y >> 16;
  }
  const int r = lane & 15, quad = lane >> 4;
  long qa8[4];
  {
    const bf16_t* qp = p.q + tok * 1024 + (kvh * 4 + (r & 3)) * 128 + quad * 16;
#pragma unroll
    for (int s = 0; s < 4; ++s) {
      const u32x4 tq = *(const u32x4*)(qp + (s >> 1) * 64 + (s & 1) * 8);
      float f[8];
#pragma unroll
      for (int e = 0; e < 4; ++e) { f[2 * e] = __uint_as_float(tq[e] << 16); f[2 * e + 1] = __uint_as_float(tq[e] & 0xffff0000u); }
      const uint2 pk = pack8_fp8(f);
      long v = (long)(((unsigned long long)pk.y << 32) | (unsigned long long)pk.x);
      if (r >= 4) v = 0;
      qa8[s] = v;
    }
  }
  __builtin_amdgcn_wave_barrier();
  const unsigned char* kb = p.k8 + ((size_t)b * SEQ) * 256 + kvh * 128 + quad * 16;
  int myidx[16];
#pragma unroll
  for (int kt = 0; kt < 16; ++kt) myidx[kt] = idx[kt * 16 + r];
#pragma unroll
  for (int kt0 = 0; kt0 < 16; kt0 += 8) {
    u32x4 kraw[8][2];
#pragma unroll
    for (int u = 0; u < 8; ++u) {
      const unsigned char* kp = kb + (size_t)myidx[kt0 + u] * 256;
      kraw[u][0] = *(const u32x4*)kp; kraw[u][1] = *(const u32x4*)(kp + 64);
    }
#pragma unroll
    for (int u = 0; u < 8; ++u) {
      const int n = (kt0 + u) * 16 + r;
      f32x4 acc = {0.f, 0.f, 0.f, 0.f};
#pragma unroll
      for (int S = 0; S < 2; ++S) {
        const long k0 = (long)(((unsigned long long)kraw[u][S][1] << 32) | (unsigned long long)kraw[u][S][0]);
        const long k1 = (long)(((unsigned long long)kraw[u][S][3] << 32) | (unsigned long long)kraw[u][S][2]);
        acc = __builtin_amdgcn_mfma_f32_16x16x32_fp8_fp8(qa8[2 * S], k0, acc, 0, 0, 0);
        acc = __builtin_amdgcn_mfma_f32_16x16x32_fp8_fp8(qa8[2 * S + 1], k1, acc, 0, 0, 0);
      }
      if (quad == 0) {
        const bool ok = n < cnt;
#pragma unroll
        for (int h = 0; h < 4; ++h) L[h * 256 + n] = ok ? acc[h] * ATT_SCALE : -INFINITY;
      }
    }
  }
  __builtin_amdgcn_wave_barrier();
  float pr[4][4];
#pragma unroll
  for (int h = 0; h < 4; ++h) {
    float m = -INFINITY;
#pragma unroll
    for (int j = 0; j < 4; ++j) { pr[h][j] = L[h * 256 + lane + 64 * j]; m = fmaxf(m, pr[h][j]); }
#pragma unroll
    for (int off = 32; off >= 1; off >>= 1) m = fmaxf(m, __shfl_xor(m, off));
    float sum = 0.f;
#pragma unroll
    for (int j = 0; j < 4; ++j) { pr[h][j] = __expf(pr[h][j] - m); sum += pr[h][j]; }
#pragma unroll
    for (int off = 32; off >= 1; off >>= 1) sum += __shfl_xor(sum, off);
    const float inv = 1.f / sum;
#pragma unroll
    for (int j = 0; j < 4; ++j) pr[h][j] *= inv;
  }
  __builtin_amdgcn_wave_barrier();
#pragma unroll
  for (int j = 0; j < 4; ++j) *(float4*)(L + (lane + 64 * j) * 4) = make_float4(pr[0][j], pr[1][j], pr[2][j], pr[3][j]);
  __builtin_amdgcn_wave_barrier();
  float o[4][8];
#pragma unroll
  for (int h = 0; h < 4; ++h)
#pragma unroll
    for (int e = 0; e < 8; ++e) o[h][e] = 0.f;
  const unsigned char* vb = p.v8 + ((size_t)b * SEQ) * 256 + kvh * 128 + r * 8;
#pragma unroll 1
  for (int n0 = 0; n0 < 256; n0 += 64) {
    uint2 vv[16];
#pragma unroll
    for (int u = 0; u < 16; ++u) vv[u] = *(const uint2*)(vb + (size_t)idx[n0 + 4 * u + quad] * 256);
#pragma unroll
    for (int u = 0; u < 16; ++u) {
      const float4 p4 = *(const float4*)(L + (n0 + 4 * u + quad) * 4);
      const f32x2_t c0 = __builtin_amdgcn_cvt_pk_f32_fp8((int)vv[u].x, false), c1 = __builtin_amdgcn_cvt_pk_f32_fp8((int)vv[u].x, true);
      const f32x2_t c2 = __builtin_amdgcn_cvt_pk_f32_fp8((int)vv[u].y, false), c3 = __builtin_amdgcn_cvt_pk_f32_fp8((int)vv[u].y, true);
      const float vf[8] = {c0.x, c0.y, c1.x, c1.y, c2.x, c2.y, c3.x, c3.y};
#pragma unroll
      for (int e = 0; e < 8; ++e) {
        o[0][e] = fmaf(p4.x, vf[e], o[0][e]); o[1][e] = fmaf(p4.y, vf[e], o[1][e]);
        o[2][e] = fmaf(p4.z, vf[e], o[2][e]); o[3][e] = fmaf(p4.w, vf[e], o[3][e]);
      }
    }
  }
#pragma unroll
  for (int h = 0; h < 4; ++h)
#pragma unroll
    for (int e = 0; e < 8; ++e) { float v = o[h][e]; v += __shfl_xor(v, 16); v += __shfl_xor(v, 32); o[h][e] = v; }
  if (quad == 0) {
#pragma unroll
    for (int h = 0; h < 4; ++h) *(uint4*)(p.q + tok * 1024 + (kvh * 4 + h) * 128 + r * 8) = pack8(o[h]);
  }
}

template <int GRP>
DI void ln_items(float* X, const float* gam, const float* bet, bf16_t* u2, const float* sc, const float* sh, int item0) {
  const int tid = TIDX(), lane = tid & 63, wave = tid >> 6;
  f32x4 v[GRP][4];
#pragma unroll
  for (int g = 0; g < GRP; ++g) {
    const size_t tok = (size_t)(item0 + g) * 4 + wave;
#pragma unroll
    for (int j = 0; j < 4; ++j) v[g][j] = *(const f32x4*)(X + tok * 1024 + j * 256 + lane * 4);
  }
#pragma unroll
  for (int g = 0; g < GRP; ++g) {
    const size_t tok = (size_t)(item0 + g) * 4 + wave;
    const int b = (int)(tok >> 13);
    float s = 0.f;
#pragma unroll
    for (int j = 0; j < 4; ++j) s += v[g][j][0] + v[g][j][1] + v[g][j][2] + v[g][j][3];
#pragma unroll
    for (int off = 32; off >= 1; off >>= 1) s += __shfl_xor(s, off);
    const float mu = s * (1.f / 1024.f);
    float q = 0.f;
#pragma unroll
    for (int j = 0; j < 4; ++j)
#pragma unroll
      for (int e = 0; e < 4; ++e) { const float d = v[g][j][e] - mu; q += d * d; }
#pragma unroll
    for (int off = 32; off >= 1; off >>= 1) q += __shfl_xor(q, off);
    const float rstd = rsqrtf(q * (1.f / 1024.f) + 1e-5f);
#pragma unroll
    for (int j = 0; j < 4; ++j) {
      const int col = j * 256 + lane * 4;
      const f32x4 gg = *(const f32x4*)(gam + col), be = *(const f32x4*)(bet + col);
      f32x4 y;
#pragma unroll
      for (int e = 0; e < 4; ++e) y[e] = (v[g][j][e] - mu) * rstd * gg[e] + be[e];
      *(f32x4*)(X + tok * 1024 + col) = y;
      if (u2) {
        const f32x4 s4 = *(const f32x4*)(sc + b * 6144 + col), h4 = *(const f32x4*)(sh + b * 6144 + col);
        uint2 o;
        o.x = pack2(y[0] * (1.f + s4[0]) + h4[0], y[1] * (1.f + s4[1]) + h4[1]);
        o.y = pack2(y[2] * (1.f + s4[2]) + h4[2], y[3] * (1.f + s4[3]) + h4[3]);
        *(uint2*)(u2 + tok * 1024 + col) = o;
      }
    }
  }
}

enum { PH_PRO = 0, PH_U1, PH_INPROJ, PH_SEL, PH_SSMA, PH_ATTN, PH_SSMB, PH_CHA, PH_CHB, PH_COUNT };

DI void run_phase(const P& p, int ph, int l, int bid, int nblk, char* smem) {
  const float* modl = p.mod + (size_t)l * 8 * 6144;
  const bf16_t* wl = p.wT + (size_t)l * WO_LAYER;
  const float* xin = (l == 0) ? p.x : p.out;
  switch (ph) {
    case PH_PRO:
      for (int it = bid; it < N_PRO; it += nblk) prologue_item(p, it, smem);
      break;
    case PH_U1:
      for (int it = bid; it < NTOK / 2; it += nblk) {
        const size_t e0 = (size_t)it * 2048 + TIDX() * 8;
        const int b = (int)(e0 >> 23), col = (int)(e0 & 1023);
        const float4 x0 = *(const float4*)(xin + e0), x1 = *(const float4*)(xin + e0 + 4);
        const float4 s0 = *(const float4*)(modl + b * 6144 + 1024 + col), s1 = *(const float4*)(modl + b * 6144 + 1024 + col + 4);
        const float4 h0 = *(const float4*)(modl + b * 6144 + col), h1 = *(const float4*)(modl + b * 6144 + col + 4);
        uint4 r;
        r.x = pack2(x0.x * (1.f + s0.x) + h0.x, x0.y * (1.f + s0.y) + h0.y);
        r.y = pack2(x0.z * (1.f + s0.z) + h0.z, x0.w * (1.f + s0.w) + h0.w);
        r.z = pack2(x1.x * (1.f + s1.x) + h1.x, x1.y * (1.f + s1.y) + h1.y);
        r.w = pack2(x1.z * (1.f + s1.z) + h1.z, x1.w * (1.f + s1.w) + h1.w);
        *(uint4*)((bf16_t*)p.XA + e0) = r;
      }
      break;
    case PH_INPROJ: {
      ALoadBf16 al{(const bf16_t*)p.XA, 1024};
      EpiInproj epi{p};
      if ((nblk & 7) == 0) {
        const int x = bid & 7, j = bid >> 3, nj = nblk >> 3;
        for (int i = j; i < 64 * 19; i += nj) gemm_wide(al, wl + WO_IN, 1024, (x + 8 * (i / 19)) * 128, (i % 19) * 256, (i % 19) == 18 ? 1 : 2, smem, epi);
      } else {
        for (int it = bid; it < 512 * 19; it += nblk) gemm_wide(al, wl + WO_IN, 1024, (it / 19) * 128, (it % 19) * 256, (it % 19) == 18 ? 1 : 2, smem, epi);
      }
    } break;
    case PH_SEL:
      if ((nblk & 7) == 0) {
        const int b = bid & 7, j = bid >> 3, nj = nblk >> 3;
        for (int i = j; i < 2048; i += nj) select_item(p, b, 2047 - i, bid, smem);
      } else {
        for (int it = bid; it < 16384; it += nblk) select_item(p, it >> 11, 2047 - (it & 2047), bid, smem);
      }
      break;
    case PH_SSMA:
      for (int it = bid; it < 4096; it += nblk) ssm_item<false>(p, l, it, smem);
      break;
    case PH_ATTN:
      if ((nblk & 7) == 0) {
        const int b = bid & 7, j = bid >> 3, nj = nblk >> 3;
        for (int i = j; i < 4096; i += nj) attn_item(p, b, i >> 11, i & 2047, smem);
      } else {
        for (int it = bid; it < 32768; it += nblk) attn_item(p, it >> 12, (it >> 11) & 1, it & 2047, smem);
      }
      break;
    case PH_SSMB:
      for (int it = bid; it < 4096; it += nblk) ssm_item<true>(p, l, it, smem);
      break;
    case PH_CHA: {
      ALoadBf16 aglu{p.y_pre, 512}, a1{p.y_ssm, 512}, a2{p.q, 1024}, aout{p.sg_s, 1024};
      EpiGlu eglu{p, p.b_glu + l * 512};
      EpiMerge1 e1{p}; EpiMerge2 e2{p};
      EpiResid eres{xin, modl + 2048, p.XA};
#pragma unroll 1
      for (int m = bid; m < 512; m += nblk) {
        const int m0 = m * 128;
#pragma unroll 1
        for (int n = 0; n < 2; ++n) gemm_wide(aglu, wl + WO_GLU, 512, m0, n * 256, 2, smem, eglu);
        __syncthreads();
#pragma unroll 1
        for (int n = 0; n < 4; ++n) {
          gemm_wide(a1, wl + WO_PSSM, 512, m0, n * 256, 2, smem, e1);
          gemm_wide(a2, wl + WO_PATTN, 1024, m0, n * 256, 2, smem, e2);
        }
        __syncthreads();
#pragma unroll 1
        for (int n = 0; n < 4; ++n) gemm_wide(aout, wl + WO_OUT, 1024, m0, n * 256, 2, smem, eres);
        __syncthreads();
#pragma unroll 1
        for (int i = 0; i < 32; i += 4) ln_items<4>(p.XA, p.ln1_g + l * 1024, p.ln1_b + l * 1024, p.u2, modl + 4096, modl + 3072, m * 32 + i);
        __syncthreads();
      }
    } break;
    case PH_CHB: {
      ALoadBf16 agu{p.u2, 1024}, adn{p.act, DFF};
      EpiGateUp egu{p};
      EpiResid eres{p.XA, modl + 5120, p.out};
#pragma unroll 1
      for (int m = bid; m < 512; m += nblk) {
        const int m0 = m * 128;
#pragma unroll 1
        for (int n = 0; n < 22; ++n) gemm_wide(agu, wl + WO_GU, 1024, m0, ((n + (m & 3)) % 22) * 256, 2, smem, egu);
        __syncthreads();
#pragma unroll 1
        for (int n = 0; n < 4; ++n) gemm_wide(adn, wl + WO_DOWN, DFF, m0, n * 256, 2, smem, eres);
        __syncthreads();
#pragma unroll 1
        for (int i = 0; i < 32; i += 4) ln_items<4>(p.out, p.ln2_g + l * 1024, p.ln2_b + l * 1024, nullptr, nullptr, nullptr, m * 32 + i);
        __syncthreads();
      }
    } break;
  }
}

template <int PH> __global__ void __launch_bounds__(256, 2) k_phase(P p, int l) {
  extern __shared__ __attribute__((aligned(16))) char smem[];
  run_phase(p, PH, l, blockIdx.x, gridDim.x, smem);
}
template <int PH> static void launch_phase(const P& p, int l, int G, hipStream_t stream) {
  static bool attr = false;
  if (!attr) { attr = true; (void)hipFuncSetAttribute((const void*)k_phase<PH>, hipFuncAttributeMaxDynamicSharedMemorySize, LDS_BYTES); }
  hipLaunchKernelGGL((k_phase<PH>), dim3(G), dim3(256), LDS_BYTES, stream, p, l);
}

#if MEGA
__global__ void __launch_bounds__(256, 2) k_mega(P p) {
  extern __shared__ __attribute__((aligned(16))) char smem[];
  cg::grid_group grid = cg::this_grid();
  run_phase(p, PH_PRO, 0, blockIdx.x, gridDim.x, smem);
  grid.sync();
#pragma unroll 1
  for (int l = 0; l < 2; ++l) {
#pragma unroll 1
    for (int ph = PH_U1; ph < PH_COUNT; ++ph) {
      run_phase(p, ph, l, blockIdx.x, gridDim.x, smem);
      if (!(l == 1 && ph == PH_CHB)) grid.sync();
    }
  }
}
#endif


extern "C" void kernel_launch(void* const* d_in, const int* in_sizes, int n_in, void* d_out, int out_size, void* d_ws, size_t ws_size, hipStream_t stream) {
  constexpr size_t MiB = 1ull << 20;
  size_t off = 0;
  auto take = [&](size_t bytes) { size_t o = off; off += (bytes + 255) & ~(size_t)255; return o; };
  const size_t o_wT = take(2 * WO_LAYER * 2);
  const size_t o_rope128 = take(8192 * 64 * 8), o_rope64 = take(8192 * 32 * 8);
  const size_t o_ssmA = take(2 * 32 * 64 * 16), o_ssmB = take(2 * 32 * 64 * 16 * 8), o_mod = take(2 * 8 * 6144 * 4), o_E = take((size_t)8 * 32 * 64 * 64 * 8);
  const size_t o_XA = take((size_t)NTOK * 1024 * 4);
  const size_t o_sel = take((size_t)NTOK * 256 * 2);
  const size_t o_P = off;
  const size_t o_ussm = take((size_t)NTOK * 512 * 2), o_q = take((size_t)NTOK * 1024 * 2), o_k = take((size_t)NTOK * 256 * 2), o_v = take((size_t)NTOK * 256 * 2);
  const size_t o_qidx = take((size_t)NTOK * 512 * 2), o_kidx = take((size_t)NTOK * 64 * 2), o_widx = take((size_t)NTOK * 8 * 4);
  const size_t o_sgs = take((size_t)NTOK * 1024 * 2), o_sga = take((size_t)NTOK * 1024 * 2);
  const size_t o_scr = take((size_t)512 * 4 * 8192 * 4);
  const size_t total = off;
  static int state = 0, grid_blocks = 0;
  if (state == 0) {
    state = 1;
    if (n_in != 24 || out_size != NTOK * 1024 || ws_size < total) {
      fprintf(stderr, "kernel_launch: unexpected sizes n_in %d out %d ws %zu (need %zu)\n", n_in, out_size, ws_size, total);
      state = -1;
    } else {
      int dev = 0, cus = 0, per_cu = 0;
      hipGetDevice(&dev);
      hipDeviceGetAttribute(&cus, hipDeviceAttributeMultiprocessorCount, dev);
#if MEGA
      hipFuncSetAttribute((const void*)k_mega, hipFuncAttributeMaxDynamicSharedMemorySize, LDS_BYTES);
      hipOccupancyMaxActiveBlocksPerMultiprocessor(&per_cu, (const void*)k_mega, 256, LDS_BYTES);
#endif
      if (per_cu < 1) per_cu = 1;
      if (per_cu > 2) per_cu = 2;
      grid_blocks = cus * per_cu;
      if (grid_blocks > 512) grid_blocks = 512;
      (void)hipGetLastError();
    }
  }
  if (state < 0) return;
  (void)MiB; (void)in_sizes;
  char* ws = (char*)d_ws;
  P p{};
  const float** f = (const float**)&p;
  for (int i = 0; i < 24; ++i) f[i] = (const float*)d_in[i];
  p.out = (float*)d_out;
  p.wT = (bf16_t*)(ws + o_wT);
  p.rope128 = (float2*)(ws + o_rope128); p.rope64 = (float2*)(ws + o_rope64);
  p.ssmA = (float4*)(ws + o_ssmA); p.ssmB = (float2*)(ws + o_ssmB); p.mod = (float*)(ws + o_mod); p.E = (float2*)(ws + o_E);
  p.XA = (float*)(ws + o_XA);
  p.sel = (unsigned short*)(ws + o_sel);
  p.scr = (unsigned*)(ws + o_scr);
  p.u_ssm = (bf16_t*)(ws + o_ussm); p.q = (bf16_t*)(ws + o_q); p.k = (bf16_t*)(ws + o_k); p.v = (bf16_t*)(ws + o_v);
  p.k8 = (unsigned char*)(ws + o_k); p.v8 = (unsigned char*)(ws + o_v);
  p.qidx = (bf16_t*)(ws + o_qidx); p.kidx = (bf16_t*)(ws + o_kidx); p.widx = (float*)(ws + o_widx);
  p.sg_s = (bf16_t*)(ws + o_sgs); p.sg_a = (bf16_t*)(ws + o_sga);
  p.y_pre = p.qidx;
  p.y_ssm = p.u_ssm;
  p.act = (bf16_t*)(ws + o_sel);
  p.u2 = p.sg_a;
#if MEGA
  void* args[] = {&p};
  hipError_t e = hipLaunchCooperativeKernel((const void*)k_mega, dim3(grid_blocks), dim3(256), args, LDS_BYTES, stream);
  if (e != hipSuccess) fprintf(stderr, "cooperative launch failed: %s (grid %d)\n", hipGetErrorString(e), grid_blocks);
#else
  const int G = 2048;
  launch_phase<PH_PRO>(p, 0, G, stream);
  for (int l = 0; l < 2; ++l) {
    launch_phase<PH_U1>(p, l, G, stream); launch_phase<PH_INPROJ>(p, l, G, stream); launch_phase<PH_SEL>(p, l, G, stream);
    launch_phase<PH_SSMA>(p, l, G, stream); launch_phase<PH_ATTN>(p, l, G, stream); launch_phase<PH_SSMB>(p, l, G, stream);
    launch_phase<PH_CHA>(p, l, G, stream); launch_phase<PH_CHB>(p, l, G, stream);
  }
#endif
}
```

```cpp
#include <hip/hip_runtime.h>
#include <hip/hip_cooperative_groups.h>
#include <cstdio>
#include <cstdint>
namespace cg = cooperative_groups;

#ifndef DIAG_PSEUDO
#define DIAG_PSEUDO 0
#endif
#ifndef DIAG_SCALE
#define DIAG_SCALE 0
#endif
#ifndef MEGA
#define MEGA 1
#endif

typedef unsigned short bf16_t;
typedef short bf16x8 __attribute__((ext_vector_type(8)));
typedef float f32x4 __attribute__((ext_vector_type(4)));
typedef float f32x16 __attribute__((ext_vector_type(16)));
typedef unsigned u32x4 __attribute__((ext_vector_type(4)));
#define DI __device__ __forceinline__

constexpr int SEQ = 8192, NB = 8, DM = 1024, NTOK = NB * SEQ;
constexpr int DINP = 4736;
constexpr int DFF = 2816;
constexpr float ALPHA = 1.41421356237f;
constexpr float IDX_SCALE = 0.04419417382415922f;
constexpr float ATT_SCALE = 0.08838834764831845f;
constexpr int LDS_BYTES = 77824;

constexpr size_t WO_IN = 0, WO_GLU = WO_IN + (size_t)4864 * 1024, WO_PSSM = WO_GLU + 512 * 512, WO_PATTN = WO_PSSM + 1024 * 512,
                 WO_OUT = WO_PATTN + 1024 * 1024, WO_GU = WO_OUT + 1024 * 1024, WO_DOWN = WO_GU + (size_t)5632 * 1024, WO_LAYER = WO_DOWN + (size_t)1024 * DFF;

struct P {
  const float *x, *c, *w_cond, *b_cond, *w_in, *lam_re, *lam_im, *log_dt, *b_re, *b_im, *c_re, *c_im, *d_skip, *w_glu, *b_glu, *p_ssm, *p_attn, *w_out,
      *ln1_g, *ln1_b, *w_gu, *w_down, *ln2_g, *ln2_b;
  float* out;
  bf16_t* wT;
  float2* rope128;
  float2* rope64;
  float4* ssmA;
  float2* ssmB;
  float* mod;
  float2* E;
  float* XA;
  bf16_t *u_ssm, *q, *k, *v, *qidx, *kidx;
  unsigned char *k8, *v8;
  float* widx;
  bf16_t *sg_s, *sg_a;
  unsigned short* sel;
  unsigned* scr;
  bf16_t *y_pre, *y_ssm, *act, *u2;
};

DI int TIDX() { int t = __builtin_amdgcn_workitem_id_x(); asm volatile("" : "+v"(t)); return t; }
DI float bf2f(bf16_t h) { return __uint_as_float(((unsigned)h) << 16); }
DI bf16_t f2bf(float x) { return __builtin_bit_cast(bf16_t, (__bf16)x); }
typedef __bf16 hwbf16x2 __attribute__((ext_vector_type(2)));
typedef float hwf32x2 __attribute__((ext_vector_type(2)));
DI unsigned pack2(float a, float b) { const hwf32x2 f = {a, b}; return __builtin_bit_cast(unsigned, __builtin_convertvector(f, hwbf16x2)); }
DI float sigm(float x) { return __builtin_amdgcn_rcpf(1.f + __expf(-x)); }
DI uint2 pack8_fp8(const float* v) {
  int w0 = 0, w1 = 0;
  w0 = __builtin_amdgcn_cvt_pk_fp8_f32(v[0], v[1], w0, false); w0 = __builtin_amdgcn_cvt_pk_fp8_f32(v[2], v[3], w0, true);
  w1 = __builtin_amdgcn_cvt_pk_fp8_f32(v[4], v[5], w1, false); w1 = __builtin_amdgcn_cvt_pk_fp8_f32(v[6], v[7], w1, true);
  uint2 r; r.x = (unsigned)w0; r.y = (unsigned)w1; return r;
}
typedef float f32x2_t __attribute__((ext_vector_type(2)));
DI void fp8x4_to_bf16x4(unsigned w, unsigned& lo, unsigned& hi) {
  const f32x2_t a = __builtin_amdgcn_cvt_pk_f32_fp8((int)w, false), b = __builtin_amdgcn_cvt_pk_f32_fp8((int)w, true);
  lo = (__float_as_uint(a.x) >> 16) | (__float_as_uint(a.y) & 0xffff0000u);
  hi = (__float_as_uint(b.x) >> 16) | (__float_as_uint(b.y) & 0xffff0000u);
}
DI uint4 pack8(const float* v) { uint4 r; r.x = pack2(v[0], v[1]); r.y = pack2(v[2], v[3]); r.z = pack2(v[4], v[5]); r.w = pack2(v[6], v[7]); return r; }

struct ALoadBf16 {
  const bf16_t* A; int lda;
  DI u32x4 load(int row, int k) const { return *(const u32x4*)(A + (size_t)row * lda + k); }
};
struct ALoadXMod {
  const float* x; const float* sc; const float* sh;
  DI u32x4 load(int row, int k) const {
    const int b = row >> 13;
    const float4* xp = (const float4*)(x + (size_t)row * 1024 + k);
    const float4* sp = (const float4*)(sc + b * 6144 + k);
    const float4* hp = (const float4*)(sh + b * 6144 + k);
    float4 x0 = xp[0], x1 = xp[1], s0 = sp[0], s1 = sp[1], h0 = hp[0], h1 = hp[1];
    u32x4 r;
    r.x = pack2(x0.x * (1.f + s0.x) + h0.x, x0.y * (1.f + s0.y) + h0.y);
    r.y = pack2(x0.z * (1.f + s0.z) + h0.z, x0.w * (1.f + s0.w) + h0.w);
    r.z = pack2(x1.x * (1.f + s1.x) + h1.x, x1.y * (1.f + s1.y) + h1.y);
    r.w = pack2(x1.z * (1.f + s1.z) + h1.z, x1.w * (1.f + s1.w) + h1.w);
    return r;
  }
};

constexpr int LDT = 72;
constexpr int LDC = 132;

template <class AL, class EPI>
DI void gemm_tile(const AL& al, const bf16_t* __restrict__ Bt, int K, int m0, int n0, char* smem, const EPI& epi) {
  bf16_t* As = (bf16_t*)smem;
  bf16_t* Bs = As + 128 * LDT;
  float* Cs = (float*)smem;
  const int tid = TIDX(), lane = tid & 63, wave = tid >> 6, wm = wave >> 1, wn = wave & 1;
  const int lr = lane & 31, lh = lane >> 5;
  f32x16 acc[2][2];
#pragma unroll
  for (int i = 0; i < 2; ++i)
#pragma unroll
    for (int j = 0; j < 2; ++j)
#pragma unroll
      for (int r = 0; r < 16; ++r) acc[i][j][r] = 0.f;
  u32x4 ra[4], rb[4];
  const int nkt = K >> 6;
#pragma unroll
  for (int i = 0; i < 4; ++i) {
    const int c = tid + 256 * i, row = c >> 3, kc = (c & 7) * 8;
    ra[i] = al.load(m0 + row, kc);
    rb[i] = *(const u32x4*)(Bt + (size_t)(n0 + row) * K + kc);
  }
  for (int kt = 0; kt < nkt; ++kt) {
    __syncthreads();
#pragma unroll
    for (int i = 0; i < 4; ++i) {
      const int c = tid + 256 * i, row = c >> 3, kc = (c & 7) * 8;
      *(u32x4*)(As + row * LDT + kc) = ra[i];
      *(u32x4*)(Bs + row * LDT + kc) = rb[i];
    }
    __syncthreads();
    if (kt + 1 < nkt) {
      const int k0 = (kt + 1) << 6;
#pragma unroll
      for (int i = 0; i < 4; ++i) {
        const int c = tid + 256 * i, row = c >> 3, kc = (c & 7) * 8;
        ra[i] = al.load(m0 + row, k0 + kc);
        rb[i] = *(const u32x4*)(Bt + (size_t)(n0 + row) * K + k0 + kc);
      }
    }
#pragma unroll
    for (int ks = 0; ks < 4; ++ks) {
      bf16x8 a[2], b[2];
#pragma unroll
      for (int i = 0; i < 2; ++i) a[i] = *(const bf16x8*)(As + (wm * 64 + i * 32 + lr) * LDT + ks * 16 + lh * 8);
#pragma unroll
      for (int j = 0; j < 2; ++j) b[j] = *(const bf16x8*)(Bs + (wn * 64 + j * 32 + lr) * LDT + ks * 16 + lh * 8);
#pragma unroll
      for (int i = 0; i < 2; ++i)
#pragma unroll
        for (int j = 0; j < 2; ++j) acc[i][j] = __builtin_amdgcn_mfma_f32_32x32x16_bf16(a[i], b[j], acc[i][j], 0, 0, 0);
    }
  }
  __syncthreads();
#pragma unroll
  for (int i = 0; i < 2; ++i)
#pragma unroll
    for (int j = 0; j < 2; ++j)
#pragma unroll
      for (int r = 0; r < 16; ++r) {
        const int row = wm * 64 + i * 32 + (r & 3) + 8 * (r >> 2) + 4 * lh, col = wn * 64 + j * 32 + lr;
        Cs[row * LDC + col] = acc[i][j][r];
      }
  __syncthreads();
  epi(Cs, m0, n0);
}


template <class AL, class EPI>
DI void gemm_wide(const AL& al, const bf16_t* __restrict__ Bt, int K, int m0, int n0, int nhalf, char* smem, const EPI& epi) {
  bf16_t* As = (bf16_t*)smem;
  bf16_t* Bs = As + 128 * LDT;
  float* Cs = (float*)smem;
  const int tid = TIDX(), lane = tid & 63, wave = tid >> 6, wm = wave >> 1, wn = wave & 1;
  const int lr = lane & 31, lh = lane >> 5;
  f32x16 acc[2][4];
#pragma unroll
  for (int i = 0; i < 2; ++i)
#pragma unroll
    for (int j = 0; j < 4; ++j)
#pragma unroll
      for (int r = 0; r < 16; ++r) acc[i][j][r] = 0.f;
  u32x4 ra[4], rb[8];
  const int nkt = K >> 6;
#pragma unroll
  for (int i = 0; i < 8; ++i) {
    const int c = tid + 256 * i, row = c >> 3, kc = (c & 7) * 8;
    if (i < 4) ra[i] = al.load(m0 + row, kc);
    rb[i] = *(const u32x4*)(Bt + (size_t)(n0 + row) * K + kc);
  }
#pragma unroll 1
  for (int kt = 0; kt < nkt; ++kt) {
    __syncthreads();
#pragma unroll
    for (int i = 0; i < 8; ++i) {
      const int c = tid + 256 * i, row = c >> 3, kc = (c & 7) * 8;
      if (i < 4) *(u32x4*)(As + row * LDT + kc) = ra[i];
      *(u32x4*)(Bs + row * LDT + kc) = rb[i];
    }
    __syncthreads();
    if (kt + 1 < nkt) {
      const int k0 = (kt + 1) << 6;
#pragma unroll
      for (int i = 0; i < 8; ++i) {
        const int c = tid + 256 * i, row = c >> 3, kc = (c & 7) * 8;
        if (i < 4) ra[i] = al.load(m0 + row, k0 + kc);
        rb[i] = *(const u32x4*)(Bt + (size_t)(n0 + row) * K + k0 + kc);
      }
    }
    {
      bf16x8 a[2][2], b[2][4];
#pragma unroll
      for (int i = 0; i < 2; ++i) a[0][i] = *(const bf16x8*)(As + (wm * 64 + i * 32 + lr) * LDT + lh * 8);
#pragma unroll
      for (int j = 0; j < 4; ++j) b[0][j] = *(const bf16x8*)(Bs + (wn * 128 + j * 32 + lr) * LDT + lh * 8);
#pragma unroll
      for (int ks = 0; ks < 4; ++ks) {
        if (ks + 1 < 4) {
#pragma unroll
          for (int i = 0; i < 2; ++i) a[(ks + 1) & 1][i] = *(const bf16x8*)(As + (wm * 64 + i * 32 + lr) * LDT + (ks + 1) * 16 + lh * 8);
#pragma unroll
          for (int j = 0; j < 4; ++j) b[(ks + 1) & 1][j] = *(const bf16x8*)(Bs + (wn * 128 + j * 32 + lr) * LDT + (ks + 1) * 16 + lh * 8);
        }
#pragma unroll
        for (int i = 0; i < 2; ++i)
#pragma unroll
          for (int j = 0; j < 4; ++j) acc[i][j] = __builtin_amdgcn_mfma_f32_32x32x16_bf16(a[ks & 1][i], b[ks & 1][j], acc[i][j], 0, 0, 0);
        if (ks + 1 < 4) {
#pragma unroll
          for (int g = 0; g < 6; ++g) {
            __builtin_amdgcn_sched_group_barrier(0x100, 1, 0);
            __builtin_amdgcn_sched_group_barrier(0x008, 1, 0);
          }
          __builtin_amdgcn_sched_group_barrier(0x008, 2, 0);
        } else {
          __builtin_amdgcn_sched_group_barrier(0x008, 8, 0);
        }
      }
    }
  }
#pragma unroll
  for (int half = 0; half < 2; ++half) {
    __syncthreads();
    if (wn == half) {
#pragma unroll
      for (int i = 0; i < 2; ++i)
#pragma unroll
        for (int j = 0; j < 4; ++j)
#pragma unroll
          for (int r = 0; r < 16; ++r) {
            const int row = wm * 64 + i * 32 + (r & 3) + 8 * (r >> 2) + 4 * lh, col = j * 32 + lr;
            Cs[row * LDC + col] = acc[i][j][r];
          }
    }
    __syncthreads();
    if (half < nhalf) epi(Cs, m0, n0 + 128 * half);
  }
}

struct EpiInproj {
  const P& p;
  DI void operator()(const float* Cs, int m0, int n0) const {
    const int nt = n0 >> 7, tid = TIDX();
#pragma unroll 1
    for (int pass = 0; pass < 8; ++pass) {
      const int row = pass * 16 + (tid >> 4), c8 = (tid & 15) * 8;
      const size_t tok = (size_t)(m0 + row);
      const int pos = (int)(tok & 8191);
      const float* cr = Cs + row * LDC;
      float v[8];
      if (nt < 4) {
#pragma unroll
        for (int e = 0; e < 8; ++e) v[e] = cr[c8 + e];
        *(uint4*)(p.u_ssm + tok * 512 + nt * 128 + c8) = pack8(v);
      } else if (nt < 14) {
        const float2* rt = p.rope128 + pos * 64;
        if (c8 < 64) {
#pragma unroll
          for (int e = 0; e < 8; ++e) { const int c = c8 + e; const float2 cs = rt[c]; v[e] = cr[c] * cs.x - cr[c + 64] * cs.y; }
        } else {
#pragma unroll
          for (int e = 0; e < 8; ++e) { const int c = c8 + e, cc = c - 64; const float2 cs = rt[cc]; v[e] = cr[c] * cs.x + cr[cc] * cs.y; }
        }
        if (nt < 12) *(uint4*)(p.q + tok * 1024 + (nt - 4) * 128 + c8) = pack8(v);
        else *(uint2*)(p.k8 + tok * 256 + (nt - 12) * 128 + c8) = pack8_fp8(v);
      } else if (nt < 16) {
#pragma unroll
        for (int e = 0; e < 8; ++e) v[e] = cr[c8 + e];
        *(uint2*)(p.v8 + tok * 256 + (nt - 14) * 128 + c8) = pack8_fp8(v);
      } else if (nt < 20 || (nt == 20 && c8 < 64)) {
        const float2* rt = p.rope64 + pos * 32;
        const int cl = c8 & 63;
        if (cl < 32) {
#pragma unroll
          for (int e = 0; e < 8; ++e) { const int c = c8 + e; const float2 cs = rt[cl + e]; v[e] = cr[c] * cs.x - cr[c + 32] * cs.y; }
        } else {
#pragma unroll
          for (int e = 0; e < 8; ++e) { const int c = c8 + e; const float2 cs = rt[cl + e - 32]; v[e] = cr[c] * cs.x + cr[c - 32] * cs.y; }
        }
        bf16_t* dst = (nt < 20) ? (p.qidx + tok * 512 + (nt - 16) * 128 + c8) : (p.kidx + tok * 64 + c8);
        *(uint4*)dst = pack8(v);
      } else if (nt == 20) {
        if (c8 == 64) {
          float4 w0, w1;
          w0.x = cr[64] * IDX_SCALE; w0.y = cr[65] * IDX_SCALE; w0.z = cr[66] * IDX_SCALE; w0.w = cr[67] * IDX_SCALE;
          w1.x = cr[68] * IDX_SCALE; w1.y = cr[69] * IDX_SCALE; w1.z = cr[70] * IDX_SCALE; w1.w = cr[71] * IDX_SCALE;
          *(float4*)(p.widx + tok * 8) = w0; *(float4*)(p.widx + tok * 8 + 4) = w1;
        }
      } else {
#pragma unroll
        for (int e = 0; e < 8; ++e) v[e] = sigm(cr[c8 + e]);
        bf16_t* dst = (nt < 29) ? (p.sg_s + tok * 1024 + (nt - 21) * 128 + c8) : (p.sg_a + tok * 1024 + (nt - 29) * 128 + c8);
        *(uint4*)dst = pack8(v);
      }
    }
  }
};

struct EpiGlu {
  const P& p; const float* bglu;
  DI void operator()(const float* Cs, int m0, int n0) const {
    const int tid = TIDX(), c8 = (tid & 15) * 8, r0 = tid >> 4;
    u32x4 yr[8];
#pragma unroll
    for (int pass = 0; pass < 8; ++pass) yr[pass] = *(const u32x4*)(p.y_pre + (size_t)(m0 + pass * 16 + r0) * 512 + n0 + c8);
    float bg[8];
#pragma unroll
    for (int e = 0; e < 8; ++e) bg[e] = bglu[n0 + c8 + e];
#pragma unroll
    for (int pass = 0; pass < 8; ++pass) {
      const int row = pass * 16 + r0;
      const float* cr = Cs + row * LDC + c8;
      float v[8];
#pragma unroll
      for (int e = 0; e < 8; ++e) {
        const unsigned w = yr[pass][e >> 1];
        const float y = __uint_as_float((e & 1) ? (w & 0xffff0000u) : (w << 16));
        v[e] = y * sigm(cr[e] + bg[e]);
      }
      *(uint4*)(p.y_ssm + (size_t)(m0 + row) * 512 + n0 + c8) = pack8(v);
    }
  }
};

struct EpiMerge1 {
  const P& p;
  DI void operator()(const float* Cs, int m0, int n0) const {
    const int tid = TIDX(), c8 = (tid & 15) * 8, r0 = tid >> 4;
    u32x4 gr[8];
#pragma unroll
    for (int pass = 0; pass < 8; ++pass) gr[pass] = *(const u32x4*)(p.sg_s + (size_t)(m0 + pass * 16 + r0) * 1024 + n0 + c8);
#pragma unroll
    for (int pass = 0; pass < 8; ++pass) {
      const int row = pass * 16 + r0;
      const float* cr = Cs + row * LDC + c8;
      float v[8];
#pragma unroll
      for (int e = 0; e < 8; ++e) {
        const unsigned w = gr[pass][e >> 1];
        const float g = __uint_as_float((e & 1) ? (w & 0xffff0000u) : (w << 16));
        v[e] = g * cr[e];
      }
      *(uint4*)(p.sg_s + (size_t)(m0 + row) * 1024 + n0 + c8) = pack8(v);
    }
  }
};
struct EpiMerge2 {
  const P& p;
  DI void operator()(const float* Cs, int m0, int n0) const {
    const int tid = TIDX(), c8 = (tid & 15) * 8, r0 = tid >> 4;
    u32x4 gr[8], pr[8];
#pragma unroll
    for (int pass = 0; pass < 8; ++pass) {
      gr[pass] = *(const u32x4*)(p.sg_a + (size_t)(m0 + pass * 16 + r0) * 1024 + n0 + c8);
      pr[pass] = *(const u32x4*)(p.sg_s + (size_t)(m0 + pass * 16 + r0) * 1024 + n0 + c8);
    }
#pragma unroll
    for (int pass = 0; pass < 8; ++pass) {
      const int row = pass * 16 + r0;
      const float* cr = Cs + row * LDC + c8;
      float v[8];
#pragma unroll
      for (int e = 0; e < 8; ++e) {
        const unsigned wg = gr[pass][e >> 1], wp = pr[pass][e >> 1];
        const float g = __uint_as_float((e & 1) ? (wg & 0xffff0000u) : (wg << 16));
        const float pa = __uint_as_float((e & 1) ? (wp & 0xffff0000u) : (wp << 16));
        v[e] = pa + g * cr[e];
      }
      *(uint4*)(p.sg_s + (size_t)(m0 + row) * 1024 + n0 + c8) = pack8(v);
    }
  }
};
struct EpiResid {
  const float* xin; const float* gt; float* dst;
  DI void operator()(const float* Cs, int m0, int n0) const {
    const int tid = TIDX(), c8 = (tid & 15) * 8, r0 = tid >> 4;
    const int b = m0 >> 13;
    f32x4 xa[8], xb[8];
#pragma unroll
    for (int pass = 0; pass < 8; ++pass) {
      const f32x4* xs = (const f32x4*)(xin + (size_t)(m0 + pass * 16 + r0) * 1024 + n0 + c8);
      xa[pass] = xs[0]; xb[pass] = xs[1];
    }
    const f32x4* gs = (const f32x4*)(gt + b * 6144 + n0 + c8);
    const f32x4 g0 = gs[0], g1 = gs[1];
#pragma unroll
    for (int pass = 0; pass < 8; ++pass) {
      const int row = pass * 16 + r0;
      const float* cr = Cs + row * LDC + c8;
      f32x4 o0, o1;
#pragma unroll
      for (int e = 0; e < 4; ++e) { o0[e] = ALPHA * xa[pass][e] + (1.f + g0[e]) * cr[e]; o1[e] = ALPHA * xb[pass][e] + (1.f + g1[e]) * cr[4 + e]; }
      f32x4* d = (f32x4*)(dst + (size_t)(m0 + row) * 1024 + n0 + c8);
      d[0] = o0; d[1] = o1;
    }
  }
};
struct EpiGateUp {
  const P& p;
  DI void operator()(const float* Cs, int m0, int n0) const {
    const int tid = TIDX(), j = n0 >> 7;
#pragma unroll 1
    for (int pass = 0; pass < 4; ++pass) {
      const int row = pass * 32 + (tid >> 3), c8 = (tid & 7) * 8;
      const size_t tok = (size_t)(m0 + row);
      const float* cr = Cs + row * LDC + c8;
      float v[8];
#pragma unroll
      for (int e = 0; e < 8; ++e) { const float a = cr[e], bb = cr[64 + e]; v[e] = a * sigm(a) * bb; }
      *(uint4*)(p.act + tok * DFF + j * 64 + c8) = pack8(v);
    }
  }
};

DI int colmap(int mode, int n) {
  if (mode == 0) return n;
  if (mode == 1) return n < 2632 ? n : (n < 2688 ? -1 : (n < 4736 ? n - 56 : -1));
  const int j = n >> 7, r = n & 127;
  return r < 64 ? (64 * j + r) : (2816 + 64 * j + (r - 64));
}
DI void transpose_item(const float* __restrict__ src, int K, int Ns, bf16_t* __restrict__ dst, int mode, int item, char* smem) {
  float* T = (float*)smem;
  const int nkt = K >> 6, kt = item % nkt, nt = item / nkt, k0 = kt * 64, n0 = nt * 64, tid = TIDX();
  __syncthreads();
  {
    const int n = n0 + (tid & 63), sc = colmap(mode, n);
#pragma unroll 4
    for (int rr = 0; rr < 16; ++rr) {
      const int r = rr * 4 + (tid >> 6);
      T[r * 65 + (tid & 63)] = sc >= 0 ? src[(size_t)(k0 + r) * Ns + sc] : 0.f;
    }
  }
  __syncthreads();
#pragma unroll 4
  for (int rr = 0; rr < 16; ++rr) {
    const int nn = rr * 4 + (tid >> 6);
    dst[(size_t)(n0 + nn) * K + k0 + (tid & 63)] = f2bf(T[(tid & 63) * 65 + nn]);
  }
}

constexpr int TR_IN = 76 * 16, TR_GLU = 64, TR_PSSM = 16 * 8, TR_PATTN = 256, TR_OUT = 256, TR_GU = 88 * 16, TR_DOWN = 16 * 44;
constexpr int TR_LAYER = TR_IN + TR_GLU + TR_PSSM + TR_PATTN + TR_OUT + TR_GU + TR_DOWN;
constexpr int N_TR = 2 * TR_LAYER, N_COND = 2 * 192, N_ROPE = 8192 / 8, N_SSMT = (2 * 32 * 64) / 256;
constexpr int N_PRO = N_TR + N_COND + N_ROPE + N_SSMT;

DI void prologue_item(const P& p, int item, char* smem) {
  const int tid = TIDX();
  if (item < N_TR) {
    const int l = item / TR_LAYER; int it = item % TR_LAYER;
    bf16_t* wl = p.wT + (size_t)l * WO_LAYER;
    if (it < TR_IN) { transpose_item(p.w_in + (size_t)l * 1024 * 4680, 1024, 4680, wl + WO_IN, 1, it, smem); return; } it -= TR_IN;
    if (it < TR_GLU) { transpose_item(p.w_glu + (size_t)l * 512 * 512, 512, 512, wl + WO_GLU, 0, it, smem); return; } it -= TR_GLU;
    if (it < TR_PSSM) { transpose_item(p.p_ssm + (size_t)l * 512 * 1024, 512, 1024, wl + WO_PSSM, 0, it, smem); return; } it -= TR_PSSM;
    if (it < TR_PATTN) { transpose_item(p.p_attn + (size_t)l * 1024 * 1024, 1024, 1024, wl + WO_PATTN, 0, it, smem); return; } it -= TR_PATTN;
    if (it < TR_OUT) { transpose_item(p.w_out + (size_t)l * 1024 * 1024, 1024, 1024, wl + WO_OUT, 0, it, smem); return; } it -= TR_OUT;
    if (it < TR_GU) { transpose_item(p.w_gu + (size_t)l * 1024 * 5632, 1024, 5632, wl + WO_GU, 2, it, smem); return; } it -= TR_GU;
    transpose_item(p.w_down + (size_t)l * DFF * 1024, DFF, 1024, wl + WO_DOWN, 0, it, smem); return;
  }
  item -= N_TR;
  if (item < N_COND) {
    const int l = item / 192, n0 = (item % 192) * 32;
    float* sc = (float*)smem;
    float* red = sc + 8192;
    __syncthreads();
    for (int i = tid; i < 8192; i += 256) { const float cv = p.c[i]; sc[i] = cv * sigm(cv); }
    __syncthreads();
    const int nn = tid & 31, kc = tid >> 5;
    float acc[8];
#pragma unroll
    for (int b = 0; b < 8; ++b) acc[b] = 0.f;
    const float* wp = p.w_cond + ((size_t)l * 1024 + kc * 128) * 6144 + n0 + nn;
    for (int k = 0; k < 128; ++k) {
      const float w = wp[(size_t)k * 6144];
#pragma unroll
      for (int b = 0; b < 8; ++b) acc[b] += sc[b * 1024 + kc * 128 + k] * w;
    }
#pragma unroll
    for (int b = 0; b < 8; ++b) red[(kc * 8 + b) * 32 + nn] = acc[b];
    __syncthreads();
    {
      const int b = tid >> 5;
      float s = 0.f;
#pragma unroll
      for (int q = 0; q < 8; ++q) s += red[(q * 8 + b) * 32 + nn];
      p.mod[((size_t)l * 8 + b) * 6144 + n0 + nn] = s + p.b_cond[l * 6144 + n0 + nn];
    }
    return;
  }
  item -= N_COND;
  if (item < N_ROPE) {
#pragma unroll 1
    for (int k = 0; k < 3; ++k) {
      const int e = tid + 256 * k;
      const int pos = item * 8 + e / 96, j = e % 96;
      if (j < 64) {
        const float inv = (float)pow(10000.0, -(double)j / 64.0);
        const float ang = (float)pos * inv;
        p.rope128[pos * 64 + j] = make_float2((float)cos((double)ang), (float)sin((double)ang));
      } else {
        const int i = j - 64;
        const float inv = (float)pow(10000.0, -(double)i / 32.0);
        const float ang = (float)pos * inv;
        p.rope64[pos * 32 + i] = make_float2((float)cos((double)ang), (float)sin((double)ang));
      }
    }
    return;
  }
  item -= N_ROPE;
  {
    const int idx = item * 256 + tid;
    const int lg = idx >> 6;
    const double dt = exp((double)p.log_dt[lg]);
    const double lr = p.lam_re[idx], li = p.lam_im[idx];
    const double mag = exp(lr * dt), ar = mag * cos(li * dt), ai = mag * sin(li * dt);
    const double mag128 = exp(lr * dt * 128.0), ar128 = mag128 * cos(li * dt * 128.0), ai128 = mag128 * sin(li * dt * 128.0);
    const double den = lr * lr + li * li, nr = ar - 1.0;
    const double fr = (nr * lr + ai * li) / den, fi = (ai * lr - nr * li) / den;
    p.ssmA[idx] = make_float4((float)ar, (float)ai, (float)ar128, (float)ai128);
    for (int i = 0; i < 16; ++i) {
      const double br = p.b_re[(size_t)idx * 16 + i], bi = p.b_im[(size_t)idx * 16 + i];
      p.ssmB[(size_t)idx * 16 + i] = make_float2((float)(fr * br - fi * bi), (float)(fr * bi + fi * br));
    }
  }
}

template <bool FULL>
DI void ssm_item(const P& p, int l, int item, char* smem) {
  const int tid = TIDX(), lane = tid & 63, wave = tid >> 6;
  const int b = item >> 9, c = (item >> 3) & 63, g = (item & 7) * 4 + wave;
  float* H = (float*)smem + wave * (16 * 132 + 256);
  float* us = H + 16 * 132;
  const int lg = l * 32 + g;
  const float4 a4 = p.ssmA[lg * 64 + lane];
  const float ar = a4.x, ai = a4.y;
  float bbr[16], bbi[16];
  {
    const float4* bp = (const float4*)(p.ssmB + ((size_t)lg * 64 + lane) * 16);
#pragma unroll
    for (int i = 0; i < 8; ++i) { const float4 t = bp[i]; bbr[2 * i] = t.x; bbi[2 * i] = t.y; bbr[2 * i + 1] = t.z; bbi[2 * i + 1] = t.w; }
  }
  float hr = 0.f, hi = 0.f;
  const int ch = lane & 15, quad = lane >> 4;
  float creg[32];
  float dsk = 0.f;
  if (FULL) {
    const float2* Ep = p.E + ((size_t)(b * 32 + g) * 64) * 64 + lane;
    for (int cc = 0; cc < c; ++cc) {
      const float2 e = Ep[cc * 64];
      const float nhr = a4.z * hr - a4.w * hi + e.x, nhi = a4.z * hi + a4.w * hr + e.y;
      hr = nhr; hi = nhi;
    }
    const float* cp = (quad < 2 ? p.c_re : p.c_im) + ((size_t)lg * 16 + ch) * 64 + (quad & 1) * 32;
    const float sgn = quad < 2 ? 1.f : -1.f;
#pragma unroll
    for (int i = 0; i < 8; ++i) { const float4 t = ((const float4*)cp)[i]; creg[4 * i] = sgn * t.x; creg[4 * i + 1] = sgn * t.y; creg[4 * i + 2] = sgn * t.z; creg[4 * i + 3] = sgn * t.w; }
    dsk = p.d_skip[l * 512 + g * 16 + ch];
  }
  const size_t tok0 = (size_t)b * SEQ + c * 128;
  const int tt = lane >> 2, part = lane & 3;
  uint2 raw = *(const uint2*)(p.u_ssm + (tok0 + tt) * 512 + g * 16 + part * 4);
#pragma unroll 1
  for (int s = 0; s < 8; ++s) {
    float4 uf;
    uf.x = __uint_as_float(raw.x << 16); uf.y = __uint_as_float(raw.x & 0xffff0000u);
    uf.z = __uint_as_float(raw.y << 16); uf.w = __uint_as_float(raw.y & 0xffff0000u);
    __builtin_amdgcn_wave_barrier();
    *(float4*)(us + tt * 16 + part * 4) = uf;
    __builtin_amdgcn_wave_barrier();
    if (s + 1 < 8) raw = *(const uint2*)(p.u_ssm + (tok0 + (s + 1) * 16 + tt) * 512 + g * 16 + part * 4);
#pragma unroll 4
    for (int t = 0; t < 16; ++t) {
      const float4* up = (const float4*)(us + t * 16);
      const float4 u0 = up[0], u1 = up[1], u2 = up[2], u3 = up[3];
      const float uu[16] = {u0.x, u0.y, u0.z, u0.w, u1.x, u1.y, u1.z, u1.w, u2.x, u2.y, u2.z, u2.w, u3.x, u3.y, u3.z, u3.w};
      float br = 0.f, bi = 0.f;
#pragma unroll
      for (int i = 0; i < 16; ++i) { br = fmaf(bbr[i], uu[i], br); bi = fmaf(bbi[i], uu[i], bi); }
      const float nhr = ar * hr - ai * hi + br, nhi = ar * hi + ai * hr + bi;
      hr = nhr; hi = nhi;
      if (FULL) { H[t * 132 + lane] = hr; H[t * 132 + 64 + lane] = hi; }
    }
    if (FULL) {
      __builtin_amdgcn_wave_barrier();
      f32x4 acc = {0.f, 0.f, 0.f, 0.f};
      const float* hp = H + ch * 132 + quad * 32;
#pragma unroll
      for (int i = 0; i < 8; ++i) {
        const float4 hv = *(const float4*)(hp + 4 * i);
        acc = __builtin_amdgcn_mfma_f32_16x16x4f32(hv.x, creg[4 * i], acc, 0, 0, 0);
        acc = __builtin_amdgcn_mfma_f32_16x16x4f32(hv.y, creg[4 * i + 1], acc, 0, 0, 0);
        acc = __builtin_amdgcn_mfma_f32_16x16x4f32(hv.z, creg[4 * i + 2], acc, 0, 0, 0);
        acc = __builtin_amdgcn_mfma_f32_16x16x4f32(hv.w, creg[4 * i + 3], acc, 0, 0, 0);
      }
#pragma unroll
      for (int r = 0; r < 4; ++r) {
        const int tl = quad * 4 + r;
        float y = acc[r] + dsk * us[tl * 16 + ch];
        const float y3 = y * y * y;
        y = y * sigm(1.5957691216057308f * (y + 0.044715f * y3));
        p.y_pre[(tok0 + s * 16 + tl) * 512 + g * 16 + ch] = f2bf(y);
      }
    }
  }
  if (!FULL) p.E[((size_t)(b * 32 + g) * 64 + c) * 64 + lane] = make_float2(hr, hi);
}

DI unsigned mono(float f) { const unsigned u = __float_as_uint(f); return (u & 0x80000000u) ? ~u : (u | 0x80000000u); }

DI void select_item(const P& p, int b, int quad4, int bid, char* smem) {
  const int t0 = quad4 * 4;
  if (t0 < 256) return;
  const int tid = TIDX(), lane = tid & 63, wave = tid >> 6;
  unsigned* hist = (unsigned*)smem + wave * 256;
  unsigned* candi = (unsigned*)smem + 1024 + wave * 512;
  unsigned* candk = candi + 256;
  unsigned short* sc16 = (unsigned short*)((unsigned*)smem + 3072);
  unsigned* scr = p.scr + (size_t)bid * 4 * 8192;
  const size_t tok0 = (size_t)b * SEQ + t0;
  __syncthreads();
  {
    const int r = lane & 31, h = lane >> 5;
    bf16x8 a[4];
    {
      const bf16_t* qp = p.qidx + (tok0 + (r >> 3)) * 512 + (r & 7) * 64 + h * 8;
#pragma unroll
      for (int s = 0; s < 4; ++s) a[s] = *(const bf16x8*)(qp + s * 16);
    }
    float4 w[4];
#pragma unroll
    for (int q = 0; q < 4; ++q) w[q] = *(const float4*)(p.widx + (tok0 + q) * 8 + h * 4);
    const int ntile = (t0 + 4 + 31) >> 5;
    const bf16_t* kbase = p.kidx + ((size_t)b * SEQ) * 64 + h * 8;
    const int nit = (ntile - wave + 3) >> 2;
#pragma unroll 1
    for (int i0 = 0; i0 < nit; i0 += 4) {
      bf16x8 bf[4][4];
#pragma unroll
      for (int u = 0; u < 4; ++u) {
        int kt = wave + 4 * (i0 + u); kt = kt < ntile ? kt : ntile - 1;
        const bf16_t* kp = kbase + (size_t)(kt * 32 + r) * 64;
#pragma unroll
        for (int s = 0; s < 4; ++s) bf[u][s] = *(const bf16x8*)(kp + s * 16);
      }
#pragma unroll
      for (int u = 0; u < 4; ++u) {
        const int key = (wave + 4 * (i0 + u)) * 32 + r;
        f32x16 acc;
#pragma unroll
        for (int i = 0; i < 16; ++i) acc[i] = 0.f;
#pragma unroll
        for (int s = 0; s < 4; ++s) acc = __builtin_amdgcn_mfma_f32_32x32x16_bf16(a[s], bf[u][s], acc, 0, 0, 0);
        float tot[4];
#pragma unroll
        for (int q = 0; q < 4; ++q) {
          float sq = 0.f;
          sq = fmaf(fmaxf(acc[4 * q + 0], 0.f), w[q].x, sq); sq = fmaf(fmaxf(acc[4 * q + 1], 0.f), w[q].y, sq);
          sq = fmaf(fmaxf(acc[4 * q + 2], 0.f), w[q].z, sq); sq = fmaf(fmaxf(acc[4 * q + 3], 0.f), w[q].w, sq);
          tot[q] = sq + __shfl_xor(sq, 32);
        }
        if (i0 + u < nit) {
          const unsigned m0 = mono(h == 0 ? tot[0] : tot[2]), m1 = mono(h == 0 ? tot[1] : tot[3]);
          const int q0 = h * 2;
          sc16[q0 * 8192 + key] = (unsigned short)(m0 >> 16); sc16[(q0 + 1) * 8192 + key] = (unsigned short)(m1 >> 16);
          __builtin_nontemporal_store(m0, scr + q0 * 8192 + key); __builtin_nontemporal_store(m1, scr + (q0 + 1) * 8192 + key);
        }
      }
    }
  }
  __syncthreads();
  {
    const int qi = wave, n = t0 + qi + 1;
    const unsigned short* s = sc16 + qi * 8192;
    const unsigned* s32 = (const unsigned*)s;
    unsigned prefix = 0, pmask = 0, need = 256, eq_total = 0;
#pragma unroll 1
    for (int pass = 0; pass < 2; ++pass) {
      const int shift = 8 - 8 * pass;
#pragma unroll
      for (int k = 0; k < 4; ++k) hist[lane + 64 * k] = 0;
      __builtin_amdgcn_wave_barrier();
      for (int e2 = lane; 2 * e2 < n; e2 += 64) {
        const unsigned wv = s32[e2];
        const unsigned k0 = wv & 0xffffu, k1 = wv >> 16;
        if ((k0 & pmask) == prefix) atomicAdd(&hist[(k0 >> shift) & 255], 1u);
        if (2 * e2 + 1 < n && (k1 & pmask) == prefix) atomicAdd(&hist[(k1 >> shift) & 255], 1u);
      }
      __builtin_amdgcn_wave_barrier();
      const uint4 h4 = *(const uint4*)(hist + 4 * lane);
      const unsigned sum = h4.x + h4.y + h4.z + h4.w;
      unsigned incl = sum;
#pragma unroll
      for (int off = 1; off < 64; off <<= 1) { const unsigned v = __shfl_down(incl, off); if (lane + off < 64) incl += v; }
      unsigned above = incl - sum;
      const bool found = above < need && need <= incl;
      unsigned dig = 0, cnt = 0;
      if (found) {
        if (above + h4.w >= need) { dig = 3; cnt = h4.w; }
        else { above += h4.w;
          if (above + h4.z >= need) { dig = 2; cnt = h4.z; }
          else { above += h4.z;
            if (above + h4.y >= need) { dig = 1; cnt = h4.y; }
            else { above += h4.y; dig = 0; cnt = h4.x; } } }
        dig += 4 * lane;
      }
      const unsigned long long fb = __ballot(found);
      const int fl = fb ? (__ffsll((long long)fb) - 1) : 0;
      const unsigned dsel = __shfl(dig, fl), nneed = __shfl(need - above, fl), ncnt = __shfl(cnt, fl);
      prefix |= dsel << shift; pmask |= 0xffu << shift; need = nneed; eq_total = ncnt;
      __builtin_amdgcn_wave_barrier();
    }
    const unsigned thr = prefix, ngt = 256 - need;
    unsigned short* dst = p.sel + (tok0 + qi) * 256;
    const unsigned long long lm = (1ull << lane) - 1ull;
    unsigned og = 0, oe = 0;
    for (int base = 0; base < n; base += 64) {
      const int e = base + lane;
      const unsigned u = e < n ? (unsigned)s[e] : 0u;
      const bool isg = e < n && u > thr, ise = e < n && u == thr;
      const unsigned long long bg = __ballot(isg), be = __ballot(ise);
      if (isg) { const unsigned pos = og + __popcll(bg & lm); if (pos < 256u) dst[pos] = (unsigned short)e; }
      if (ise) { const unsigned rr = oe + __popcll(be & lm); if (rr < 256u) candi[rr] = (unsigned)e; }
      og += __popcll(bg); oe += __popcll(be);
    }
    __builtin_amdgcn_wave_barrier();
    const unsigned c = eq_total < 256u ? eq_total : 256u;
    if (eq_total == need) {
      for (unsigned i = lane; i < c; i += 64) if (ngt + i < 256u) dst[ngt + i] = (unsigned short)candi[i];
    } else {
      for (unsigned i = lane; i < c; i += 64) candk[i] = __hip_atomic_load(scr + qi * 8192 + candi[i], __ATOMIC_RELAXED, __HIP_MEMORY_SCOPE_AGENT);
      __builtin_amdgcn_wave_barrier();
      for (unsigned i = lane; i < c; i += 64) {
        const unsigned ki = candk[i];
        unsigned rank = 0;
        for (unsigned j2 = 0; j2 < c; ++j2) { const unsigned kj = candk[j2]; rank += (kj > ki || (kj == ki && j2 < i)) ? 1u : 0u; }
        if (rank < need && ngt + rank < 256u) dst[ngt + rank] = (unsigned short)candi[i];
      }
    }
  }
  __syncthreads();
}

DI void attn_item(const P& p, int b, int kvh, int quad4, char* smem) {
  const int tid = TIDX(), lane = tid & 63, wave = tid >> 6;
  const int t = quad4 * 4 + wave;
  const size_t tok = (size_t)b * SEQ + t;
  float* L = (float*)smem + wave * (1024 + 256);
  int* idx = (int*)(L + 1024);
  const int cnt = t < 256 ? t + 1 : 256;
  __builtin_amdgcn_wave_barrier();
  if (t < 256) {
#pragma unroll
    for (int j = 0; j < 4; ++j) { const int n = lane + 64 * j; idx[n] = n < cnt ? n : 0; }
  } else {
    const uint2 sv = *(const uint2*)(p.sel + tok * 256 + lane * 4);
    idx[lane * 4 + 0] = sv.x & 0xffff; idx[lane * 4 + 1] = sv.x >> 16; idx[lane * 4 + 2] = sv.y & 0xffff; idx[lane * 4 + 3] = sv.y >> 16;
  }
  const int r = lane & 15, quad = lane >> 4;
  long qa8[4];
  {
    const bf16_t* qp = p.q + tok * 1024 + (kvh * 4 + (r & 3)) * 128 + quad * 16;
#pragma unroll
    for (int s = 0; s < 4; ++s) {
      const u32x4 tq = *(const u32x4*)(qp + (s >> 1) * 64 + (s & 1) * 8);
      float f[8];
#pragma unroll
      for (int e = 0; e < 4; ++e) { f[2 * e] = __uint_as_float(tq[e] << 16); f[2 * e + 1] = __uint_as_float(tq[e] & 0xffff0000u); }
      const uint2 pk = pack8_fp8(f);
      long v = (long)(((unsigned long long)pk.y << 32) | (unsigned long long)pk.x);
      if (r >= 4) v = 0;
      qa8[s] = v;
    }
  }
  __builtin_amdgcn_wave_barrier();
  const unsigned char* kb = p.k8 + ((size_t)b * SEQ) * 256 + kvh * 128 + quad * 16;
  int myidx[16];
#pragma unroll
  for (int kt = 0; kt < 16; ++kt) myidx[kt] = idx[kt * 16 + r];
#pragma unroll
  for (int kt0 = 0; kt0 < 16; kt0 += 8) {
    u32x4 kraw[8][2];
#pragma unroll
    for (int u = 0; u < 8; ++u) {
      const unsigned char* kp = kb + (size_t)myidx[kt0 + u] * 256;
      kraw[u][0] = *(const u32x4*)kp; kraw[u][1] = *(const u32x4*)(kp + 64);
    }
#pragma unroll
    for (int u = 0; u < 8; ++u) {
      const int n = (kt0 + u) * 16 + r;
      f32x4 acc = {0.f, 0.f, 0.f, 0.f};
#pragma unroll
      for (int S = 0; S < 2; ++S) {
        const long k0 = (long)(((unsigned long long)kraw[u][S][1] << 32) | (unsigned long long)kraw[u][S][0]);
        const long k1 = (long)(((unsigned long long)kraw[u][S][3] << 32) | (unsigned long long)kraw[u][S][2]);
        acc = __builtin_amdgcn_mfma_f32_16x16x32_fp8_fp8(qa8[2 * S], k0, acc, 0, 0, 0);
        acc = __builtin_amdgcn_mfma_f32_16x16x32_fp8_fp8(qa8[2 * S + 1], k1, acc, 0, 0, 0);
      }
      if (quad == 0) {
        const bool ok = n < cnt;
#pragma unroll
        for (int h = 0; h < 4; ++h) L[h * 256 + n] = ok ? acc[h] * ATT_SCALE : -INFINITY;
      }
    }
  }
  __builtin_amdgcn_wave_barrier();
  float pr[4][4];
#pragma unroll
  for (int h = 0; h < 4; ++h) {
    float m = -INFINITY;
#pragma unroll
    for (int j = 0; j < 4; ++j) { pr[h][j] = L[h * 256 + lane + 64 * j]; m = fmaxf(m, pr[h][j]); }
#pragma unroll
    for (int off = 32; off >= 1; off >>= 1) m = fmaxf(m, __shfl_xor(m, off));
    float sum = 0.f;
#pragma unroll
    for (int j = 0; j < 4; ++j) { pr[h][j] = __expf(pr[h][j] - m); sum += pr[h][j]; }
#pragma unroll
    for (int off = 32; off >= 1; off >>= 1) sum += __shfl_xor(sum, off);
    const float inv = 1.f / sum;
#pragma unroll
    for (int j = 0; j < 4; ++j) pr[h][j] *= inv;
  }
  __builtin_amdgcn_wave_barrier();
#pragma unroll
  for (int j = 0; j < 4; ++j) *(float4*)(L + (lane + 64 * j) * 4) = make_float4(pr[0][j], pr[1][j], pr[2][j], pr[3][j]);
  __builtin_amdgcn_wave_barrier();
  float o[4][8];
#pragma unroll
  for (int h = 0; h < 4; ++h)
#pragma unroll
    for (int e = 0; e < 8; ++e) o[h][e] = 0.f;
  const unsigned char* vb = p.v8 + ((size_t)b * SEQ) * 256 + kvh * 128 + r * 8;
#pragma unroll 1
  for (int n0 = 0; n0 < 256; n0 += 64) {
    uint2 vv[16];
#pragma unroll
    for (int u = 0; u < 16; ++u) vv[u] = *(const uint2*)(vb + (size_t)idx[n0 + 4 * u + quad] * 256);
#pragma unroll
    for (int u = 0; u < 16; ++u) {
      const float4 p4 = *(const float4*)(L + (n0 + 4 * u + quad) * 4);
      const f32x2_t c0 = __builtin_amdgcn_cvt_pk_f32_fp8((int)vv[u].x, false), c1 = __builtin_amdgcn_cvt_pk_f32_fp8((int)vv[u].x, true);
      const f32x2_t c2 = __builtin_amdgcn_cvt_pk_f32_fp8((int)vv[u].y, false), c3 = __builtin_amdgcn_cvt_pk_f32_fp8((int)vv[u].y, true);
      const float vf[8] = {c0.x, c0.y, c1.x, c1.y, c2.x, c2.y, c3.x, c3.y};
#pragma unroll
      for (int e = 0; e < 8; ++e) {
        o[0][e] = fmaf(p4.x, vf[e], o[0][e]); o[1][e] = fmaf(p4.y, vf[e], o[1][e]);
        o[2][e] = fmaf(p4.z, vf[e], o[2][e]); o[3][e] = fmaf(p4.w, vf[e], o[3][e]);
      }
    }
  }
#pragma unroll
  for (int h = 0; h < 4; ++h)
#pragma unroll
    for (int e = 0; e < 8; ++e) { float v = o[h][e]; v += __shfl_xor(v, 16); v += __shfl_xor(v, 32); o[h][e] = v; }
  if (quad == 0) {
#pragma unroll
    for (int h = 0; h < 4; ++h) *(uint4*)(p.q + tok * 1024 + (kvh * 4 + h) * 128 + r * 8) = pack8(o[h]);
  }
}

template <int GRP>
DI void ln_items(float* X, const float* gam, const float* bet, bf16_t* u2, const float* sc, const float* sh, int item0) {
  const int tid = TIDX(), lane = tid & 63, wave = tid >> 6;
  f32x4 v[GRP][4];
#pragma unroll
  for (int g = 0; g < GRP; ++g) {
    const size_t tok = (size_t)(item0 + g) * 4 + wave;
#pragma unroll
    for (int j = 0; j < 4; ++j) v[g][j] = *(const f32x4*)(X + tok * 1024 + j * 256 + lane * 4);
  }
#pragma unroll
  for (int g = 0; g < GRP; ++g) {
    const size_t tok = (size_t)(item0 + g) * 4 + wave;
    const int b = (int)(tok >> 13);
    float s = 0.f;
#pragma unroll
    for (int j = 0; j < 4; ++j) s += v[g][j][0] + v[g][j][1] + v[g][j][2] + v[g][j][3];
#pragma unroll
    for (int off = 32; off >= 1; off >>= 1) s += __shfl_xor(s, off);
    const float mu = s * (1.f / 1024.f);
    float q = 0.f;
#pragma unroll
    for (int j = 0; j < 4; ++j)
#pragma unroll
      for (int e = 0; e < 4; ++e) { const float d = v[g][j][e] - mu; q += d * d; }
#pragma unroll
    for (int off = 32; off >= 1; off >>= 1) q += __shfl_xor(q, off);
    const float rstd = rsqrtf(q * (1.f / 1024.f) + 1e-5f);
#pragma unroll
    for (int j = 0; j < 4; ++j) {
      const int col = j * 256 + lane * 4;
      const f32x4 gg = *(const f32x4*)(gam + col), be = *(const f32x4*)(bet + col);
      f32x4 y;
#pragma unroll
      for (int e = 0; e < 4; ++e) y[e] = (v[g][j][e] - mu) * rstd * gg[e] + be[e];
      *(f32x4*)(X + tok * 1024 + col) = y;
      if (u2) {
        const f32x4 s4 = *(const f32x4*)(sc + b * 6144 + col), h4 = *(const f32x4*)(sh + b * 6144 + col);
        uint2 o;
        o.x = pack2(y[0] * (1.f + s4[0]) + h4[0], y[1] * (1.f + s4[1]) + h4[1]);
        o.y = pack2(y[2] * (1.f + s4[2]) + h4[2], y[3] * (1.f + s4[3]) + h4[3]);
        *(uint2*)(u2 + tok * 1024 + col) = o;
      }
    }
  }
}

enum { PH_PRO = 0, PH_U1, PH_INPROJ, PH_SEL, PH_SSMA, PH_ATTN, PH_SSMB, PH_CHA, PH_CHB, PH_COUNT };

DI void run_phase(const P& p, int ph, int l, int bid, int nblk, char* smem) {
  const float* modl = p.mod + (size_t)l * 8 * 6144;
  const bf16_t* wl = p.wT + (size_t)l * WO_LAYER;
  const float* xin = (l == 0) ? p.x : p.out;
  switch (ph) {
    case PH_PRO:
      for (int it = bid; it < N_PRO; it += nblk) prologue_item(p, it, smem);
      break;
    case PH_U1:
      for (int it = bid; it < NTOK / 2; it += nblk) {
        const size_t e0 = (size_t)it * 2048 + TIDX() * 8;
        const int b = (int)(e0 >> 23), col = (int)(e0 & 1023);
        const float4 x0 = *(const float4*)(xin + e0), x1 = *(const float4*)(xin + e0 + 4);
        const float4 s0 = *(const float4*)(modl + b * 6144 + 1024 + col), s1 = *(const float4*)(modl + b * 6144 + 1024 + col + 4);
        const float4 h0 = *(const float4*)(modl + b * 6144 + col), h1 = *(const float4*)(modl + b * 6144 + col + 4);
        uint4 r;
        r.x = pack2(x0.x * (1.f + s0.x) + h0.x, x0.y * (1.f + s0.y) + h0.y);
        r.y = pack2(x0.z * (1.f + s0.z) + h0.z, x0.w * (1.f + s0.w) + h0.w);
        r.z = pack2(x1.x * (1.f + s1.x) + h1.x, x1.y * (1.f + s1.y) + h1.y);
        r.w = pack2(x1.z * (1.f + s1.z) + h1.z, x1.w * (1.f + s1.w) + h1.w);
        *(uint4*)((bf16_t*)p.XA + e0) = r;
      }
      break;
    case PH_INPROJ: {
      ALoadBf16 al{(const bf16_t*)p.XA, 1024};
      EpiInproj epi{p};
      if ((nblk & 7) == 0) {
        const int x = bid & 7, j = bid >> 3, nj = nblk >> 3;
        for (int i = j; i < 64 * 19; i += nj) gemm_wide(al, wl + WO_IN, 1024, (x + 8 * (i / 19)) * 128, (i % 19) * 256, (i % 19) == 18 ? 1 : 2, smem, epi);
      } else {
        for (int it = bid; it < 512 * 19; it += nblk) gemm_wide(al, wl + WO_IN, 1024, (it / 19) * 128, (it % 19) * 256, (it % 19) == 18 ? 1 : 2, smem, epi);
      }
    } break;
    case PH_SEL:
      if ((nblk & 7) == 0) {
        const int b = bid & 7, j = bid >> 3, nj = nblk >> 3;
        for (int i = j; i < 2048; i += nj) select_item(p, b, 2047 - i, bid, smem);
      } else {
        for (int it = bid; it < 16384; it += nblk) select_item(p, it >> 11, 2047 - (it & 2047), bid, smem);
      }
      break;
    case PH_SSMA:
      for (int it = bid; it < 4096; it += nblk) ssm_item<false>(p, l, it, smem);
      break;
    case PH_ATTN:
      if ((nblk & 7) == 0) {
        const int b = bid & 7, j = bid >> 3, nj = nblk >> 3;
        for (int i = j; i < 4096; i += nj) attn_item(p, b, i >> 11, i & 2047, smem);
      } else {
        for (int it = bid; it < 32768; it += nblk) attn_item(p, it >> 12, (it >> 11) & 1, it & 2047, smem);
      }
      break;
    case PH_SSMB:
      for (int it = bid; it < 4096; it += nblk) ssm_item<true>(p, l, it, smem);
      break;
    case PH_CHA: {
      ALoadBf16 aglu{p.y_pre, 512}, a1{p.y_ssm, 512}, a2{p.q, 1024}, aout{p.sg_s, 1024};
      EpiGlu eglu{p, p.b_glu + l * 512};
      EpiMerge1 e1{p}; EpiMerge2 e2{p};
      EpiResid eres{xin, modl + 2048, p.XA};
#pragma unroll 1
      for (int m = bid; m < 512; m += nblk) {
        const int m0 = m * 128;
#pragma unroll 1
        for (int n = 0; n < 2; ++n) gemm_wide(aglu, wl + WO_GLU, 512, m0, n * 256, 2, smem, eglu);
        __syncthreads();
#pragma unroll 1
        for (int n = 0; n < 4; ++n) {
          gemm_wide(a1, wl + WO_PSSM, 512, m0, n * 256, 2, smem, e1);
          gemm_wide(a2, wl + WO_PATTN, 1024, m0, n * 256, 2, smem, e2);
        }
        __syncthreads();
#pragma unroll 1
        for (int n = 0; n < 4; ++n) gemm_wide(aout, wl + WO_OUT, 1024, m0, n * 256, 2, smem, eres);
        __syncthreads();
#pragma unroll 1
        for (int i = 0; i < 32; i += 4) ln_items<4>(p.XA, p.ln1_g + l * 1024, p.ln1_b + l * 1024, p.u2, modl + 4096, modl + 3072, m * 32 + i);
        __syncthreads();
      }
    } break;
    case PH_CHB: {
      ALoadBf16 agu{p.u2, 1024}, adn{p.act, DFF};
      EpiGateUp egu{p};
      EpiResid eres{p.XA, modl + 5120, p.out};
#pragma unroll 1
      for (int m = bid; m < 512; m += nblk) {
        const int m0 = m * 128;
#pragma unroll 1
        for (int n = 0; n < 22; ++n) gemm_wide(agu, wl + WO_GU, 1024, m0, ((n + (m & 3)) % 22) * 256, 2, smem, egu);
        __syncthreads();
#pragma unroll 1
        for (int n = 0; n < 4; ++n) gemm_wide(adn, wl + WO_DOWN, DFF, m0, n * 256, 2, smem, eres);
        __syncthreads();
#pragma unroll 1
        for (int i = 0; i < 32; i += 4) ln_items<4>(p.out, p.ln2_g + l * 1024, p.ln2_b + l * 1024, nullptr, nullptr, nullptr, m * 32 + i);
        __syncthreads();
      }
    } break;
  }
}

template <int PH> __global__ void __launch_bounds__(256, 2) k_phase(P p, int l) {
  extern __shared__ __attribute__((aligned(16))) char smem[];
  run_phase(p, PH, l, blockIdx.x, gridDim.x, smem);
}
template <int PH> static void launch_phase(const P& p, int l, int G, hipStream_t stream) {
  static bool attr = false;
  if (!attr) { attr = true; (void)hipFuncSetAttribute((const void*)k_phase<PH>, hipFuncAttributeMaxDynamicSharedMemorySize, LDS_BYTES); }
  hipLaunchKernelGGL((k_phase<PH>), dim3(G), dim3(256), LDS_BYTES, stream, p, l);
}

#if MEGA
__global__ void __launch_bounds__(256, 2) k_mega(P p) {
  extern __shared__ __attribute__((aligned(16))) char smem[];
  cg::grid_group grid = cg::this_grid();
  run_phase(p, PH_PRO, 0, blockIdx.x, gridDim.x, smem);
  grid.sync();
#pragma unroll 1
  for (int l = 0; l < 2; ++l) {
#pragma unroll 1
    for (int ph = PH_U1; ph < PH_COUNT; ++ph) {
      run_phase(p, ph, l, blockIdx.x, gridDim.x, smem);
      if (!(l == 1 && ph == PH_CHB)) grid.sync();
    }
  }
}
#endif


extern "C" void kernel_launch(void* const* d_in, const int* in_sizes, int n_in, void* d_out, int out_size, void* d_ws, size_t ws_size, hipStream_t stream) {
  constexpr size_t MiB = 1ull << 20;
  size_t off = 0;
  auto take = [&](size_t bytes) { size_t o = off; off += (bytes + 255) & ~(size_t)255; return o; };
  const size_t o_wT = take(2 * WO_LAYER * 2);
  const size_t o_rope128 = take(8192 * 64 * 8), o_rope64 = take(8192 * 32 * 8);
  const size_t o_ssmA = take(2 * 32 * 64 * 16), o_ssmB = take(2 * 32 * 64 * 16 * 8), o_mod = take(2 * 8 * 6144 * 4), o_E = take((size_t)8 * 32 * 64 * 64 * 8);
  const size_t o_XA = take((size_t)NTOK * 1024 * 4);
  const size_t o_sel = take((size_t)NTOK * 256 * 2);
  const size_t o_P = off;
  const size_t o_ussm = take((size_t)NTOK * 512 * 2), o_q = take((size_t)NTOK * 1024 * 2), o_k = take((size_t)NTOK * 256 * 2), o_v = take((size_t)NTOK * 256 * 2);
  const size_t o_qidx = take((size_t)NTOK * 512 * 2), o_kidx = take((size_t)NTOK * 64 * 2), o_widx = take((size_t)NTOK * 8 * 4);
  const size_t o_sgs = take((size_t)NTOK * 1024 * 2), o_sga = take((size_t)NTOK * 1024 * 2);
  const size_t o_scr = take((size_t)512 * 4 * 8192 * 4);
  const size_t total = off;
  static int state = 0, grid_blocks = 0;
  if (state == 0) {
    state = 1;
    if (n_in != 24 || out_size != NTOK * 1024 || ws_size < total) {
      fprintf(stderr, "kernel_launch: unexpected sizes n_in %d out %d ws %zu (need %zu)\n", n_in, out_size, ws_size, total);
      state = -1;
    } else {
      int dev = 0, cus = 0, per_cu = 0;
      hipGetDevice(&dev);
      hipDeviceGetAttribute(&cus, hipDeviceAttributeMultiprocessorCount, dev);
#if MEGA
      hipFuncSetAttribute((const void*)k_mega, hipFuncAttributeMaxDynamicSharedMemorySize, LDS_BYTES);
      hipOccupancyMaxActiveBlocksPerMultiprocessor(&per_cu, (const void*)k_mega, 256, LDS_BYTES);
#endif
      if (per_cu < 1) per_cu = 1;
      if (per_cu > 2) per_cu = 2;
      grid_blocks = cus * per_cu;
      if (grid_blocks > 512) grid_blocks = 512;
      (void)hipGetLastError();
    }
  }
  if (state < 0) return;
  (void)MiB; (void)in_sizes;
  char* ws = (char*)d_ws;
  P p{};
  const float** f = (const float**)&p;
  for (int i = 0; i < 24; ++i) f[i] = (const float*)d_in[i];
  p.out = (float*)d_out;
  p.wT = (bf16_t*)(ws + o_wT);
  p.rope128 = (float2*)(ws + o_rope128); p.rope64 = (float2*)(ws + o_rope64);
  p.ssmA = (float4*)(ws + o_ssmA); p.ssmB = (float2*)(ws + o_ssmB); p.mod = (float*)(ws + o_mod); p.E = (float2*)(ws + o_E);
  p.XA = (float*)(ws + o_XA);
  p.sel = (unsigned short*)(ws + o_sel);
  p.scr = (unsigned*)(ws + o_scr);
  p.u_ssm = (bf16_t*)(ws + o_ussm); p.q = (bf16_t*)(ws + o_q); p.k = (bf16_t*)(ws + o_k); p.v = (bf16_t*)(ws + o_v);
  p.k8 = (unsigned char*)(ws + o_k); p.v8 = (unsigned char*)(ws + o_v);
  p.qidx = (bf16_t*)(ws + o_qidx); p.kidx = (bf16_t*)(ws + o_kidx); p.widx = (float*)(ws + o_widx);
  p.sg_s = (bf16_t*)(ws + o_sgs); p.sg_a = (bf16_t*)(ws + o_sga);
  p.y_pre = p.qidx;
  p.y_ssm = p.u_ssm;
  p.act = (bf16_t*)(ws + o_sel);
  p.u2 = p.sg_a;
#if MEGA
  void* args[] = {&p};
  hipError_t e = hipLaunchCooperativeKernel((const void*)k_mega, dim3(grid_blocks), dim3(256), args, LDS_BYTES, stream);
  if (e != hipSuccess) fprintf(stderr, "cooperative launch failed: %s (grid %d)\n", hipGetErrorString(e), grid_blocks);
#else
  const int G = 2048;
  launch_phase<PH_PRO>(p, 0, G, stream);
  for (int l = 0; l < 2; ++l) {
    launch_phase<PH_U1>(p, l, G, stream); launch_phase<PH_INPROJ>(p, l, G, stream); launch_phase<PH_SEL>(p, l, G, stream);
    launch_phase<PH_SSMA>(p, l, G, stream); launch_phase<PH_ATTN>(p, l, G, stream); launch_phase<PH_SSMB>(p, l, G, stream);
    launch_phase<PH_CHA>(p, l, G, stream); launch_phase<PH_CHB>(p, l, G, stream);
  }
#endif
}
```

```cpp
#include <hip/hip_runtime.h>
#include <hip/hip_cooperative_groups.h>
#include <cstdio>
#include <cstdint>
namespace cg = cooperative_groups;

#ifndef DIAG_PSEUDO
#define DIAG_PSEUDO 0
#endif
#ifndef DIAG_SCALE
#define DIAG_SCALE 0
#endif
#ifndef MEGA
#define MEGA 1
#endif

typedef unsigned short bf16_t;
typedef short bf16x8 __attribute__((ext_vector_type(8)));
typedef float f32x4 __attribute__((ext_vector_type(4)));
typedef float f32x16 __attribute__((ext_vector_type(16)));
typedef unsigned u32x4 __attribute__((ext_vector_type(4)));
#define DI __device__ __forceinline__

constexpr int SEQ = 8192, NB = 8, DM = 1024, NTOK = NB * SEQ;
constexpr int DINP = 4736;
constexpr int DFF = 2816;
constexpr float ALPHA = 1.41421356237f;
constexpr float IDX_SCALE = 0.04419417382415922f;
constexpr float ATT_SCALE = 0.08838834764831845f;
constexpr int LDS_BYTES = 77824;

constexpr size_t WO_IN = 0, WO_GLU = WO_IN + (size_t)4864 * 1024, WO_PSSM = WO_GLU + 512 * 512, WO_PATTN = WO_PSSM + 1024 * 512,
                 WO_OUT = WO_PATTN + 1024 * 1024, WO_GU = WO_OUT + 1024 * 1024, WO_DOWN = WO_GU + (size_t)5632 * 1024, WO_LAYER = WO_DOWN + (size_t)1024 * DFF;

struct P {
  const float *x, *c, *w_cond, *b_cond, *w_in, *lam_re, *lam_im, *log_dt, *b_re, *b_im, *c_re, *c_im, *d_skip, *w_glu, *b_glu, *p_ssm, *p_attn, *w_out,
      *ln1_g, *ln1_b, *w_gu, *w_down, *ln2_g, *ln2_b;
  float* out;
  bf16_t* wT;
  float2* rope128;
  float2* rope64;
  float4* ssmA;
  float2* ssmB;
  float* mod;
  float2* E;
  float* XA;
  bf16_t *u_ssm, *q, *k, *v, *qidx, *kidx;
  unsigned char *k8, *v8;
  float* widx;
  bf16_t *sg_s, *sg_a;
  unsigned short* sel;
  unsigned* scr;
  bf16_t *y_pre, *y_ssm, *act, *u2;
};

DI int TIDX() { int t = __builtin_amdgcn_workitem_id_x(); asm volatile("" : "+v"(t)); return t; }
DI float bf2f(bf16_t h) { return __uint_as_float(((unsigned)h) << 16); }
DI bf16_t f2bf(float x) { return __builtin_bit_cast(bf16_t, (__bf16)x); }
typedef __bf16 hwbf16x2 __attribute__((ext_vector_type(2)));
typedef float hwf32x2 __attribute__((ext_vector_type(2)));
DI unsigned pack2(float a, float b) { const hwf32x2 f = {a, b}; return __builtin_bit_cast(unsigned, __builtin_convertvector(f, hwbf16x2)); }
DI float sigm(float x) { return __builtin_amdgcn_rcpf(1.f + __expf(-x)); }
DI uint2 pack8_fp8(const float* v) {
  int w0 = 0, w1 = 0;
  w0 = __builtin_amdgcn_cvt_pk_fp8_f32(v[0], v[1], w0, false); w0 = __builtin_amdgcn_cvt_pk_fp8_f32(v[2], v[3], w0, true);
  w1 = __builtin_amdgcn_cvt_pk_fp8_f32(v[4], v[5], w1, false); w1 = __builtin_amdgcn_cvt_pk_fp8_f32(v[6], v[7], w1, true);
  uint2 r; r.x = (unsigned)w0; r.y = (unsigned)w1; return r;
}
typedef float f32x2_t __attribute__((ext_vector_type(2)));
DI void fp8x4_to_bf16x4(unsigned w, unsigned& lo, unsigned& hi) {
  const f32x2_t a = __builtin_amdgcn_cvt_pk_f32_fp8((int)w, false), b = __builtin_amdgcn_cvt_pk_f32_fp8((int)w, true);
  lo = (__float_as_uint(a.x) >> 16) | (__float_as_uint(a.y) & 0xffff0000u);
  hi = (__float_as_uint(b.x) >> 16) | (__float_as_uint(b.y) & 0xffff0000u);
}
DI uint4 pack8(const float* v) { uint4 r; r.x = pack2(v[0], v[1]); r.y = pack2(v[2], v[3]); r.z = pack2(v[4], v[5]); r.w = pack2(v[6], v[7]); return r; }

struct ALoadBf16 {
  const bf16_t* A; int lda;
  DI u32x4 load(int row, int k) const { return *(const u32x4*)(A + (size_t)row * lda + k); }
};
struct ALoadXMod {
  const float* x; const float* sc; const float* sh;
  DI u32x4 load(int row, int k) const {
    const int b = row >> 13;
    const float4* xp = (const float4*)(x + (size_t)row * 1024 + k);
    const float4* sp = (const float4*)(sc + b * 6144 + k);
    const float4* hp = (const float4*)(sh + b * 6144 + k);
    float4 x0 = xp[0], x1 = xp[1], s0 = sp[0], s1 = sp[1], h0 = hp[0], h1 = hp[1];
    u32x4 r;
    r.x = pack2(x0.x * (1.f + s0.x) + h0.x, x0.y * (1.f + s0.y) + h0.y);
    r.y = pack2(x0.z * (1.f + s0.z) + h0.z, x0.w * (1.f + s0.w) + h0.w);
    r.z = pack2(x1.x * (1.f + s1.x) + h1.x, x1.y * (1.f + s1.y) + h1.y);
    r.w = pack2(x1.z * (1.f + s1.z) + h1.z, x1.w * (1.f + s1.w) + h1.w);
    return r;
  }
};

constexpr int LDT = 72;
constexpr int LDC = 132;

template <class AL, class EPI>
DI void gemm_tile(const AL& al, const bf16_t* __restrict__ Bt, int K, int m0, int n0, char* smem, const EPI& epi) {
  bf16_t* As = (bf16_t*)smem;
  bf16_t* Bs = As + 128 * LDT;
  float* Cs = (float*)smem;
  const int tid = TIDX(), lane = tid & 63, wave = tid >> 6, wm = wave >> 1, wn = wave & 1;
  const int lr = lane & 31, lh = lane >> 5;
  f32x16 acc[2][2];
#pragma unroll
  for (int i = 0; i < 2; ++i)
#pragma unroll
    for (int j = 0; j < 2; ++j)
#pragma unroll
      for (int r = 0; r < 16; ++r) acc[i][j][r] = 0.f;
  u32x4 ra[4], rb[4];
  const int nkt = K >> 6;
#pragma unroll
  for (int i = 0; i < 4; ++i) {
    const int c = tid + 256 * i, row = c >> 3, kc = (c & 7) * 8;
    ra[i] = al.load(m0 + row, kc);
    rb[i] = *(const u32x4*)(Bt + (size_t)(n0 + row) * K + kc);
  }
  for (int kt = 0; kt < nkt; ++kt) {
    __syncthreads();
#pragma unroll
    for (int i = 0; i < 4; ++i) {
      const int c = tid + 256 * i, row = c >> 3, kc = (c & 7) * 8;
      *(u32x4*)(As + row * LDT + kc) = ra[i];
      *(u32x4*)(Bs + row * LDT + kc) = rb[i];
    }
    __syncthreads();
    if (kt + 1 < nkt) {
      const int k0 = (kt + 1) << 6;
#pragma unroll
      for (int i = 0; i < 4; ++i) {
        const int c = tid + 256 * i, row = c >> 3, kc = (c & 7) * 8;
        ra[i] = al.load(m0 + row, k0 + kc);
        rb[i] = *(const u32x4*)(Bt + (size_t)(n0 + row) * K + k0 + kc);
      }
    }
#pragma unroll
    for (int ks = 0; ks < 4; ++ks) {
      bf16x8 a[2], b[2];
#pragma unroll
      for (int i = 0; i < 2; ++i) a[i] = *(const bf16x8*)(As + (wm * 64 + i * 32 + lr) * LDT + ks * 16 + lh * 8);
#pragma unroll
      for (int j = 0; j < 2; ++j) b[j] = *(const bf16x8*)(Bs + (wn * 64 + j * 32 + lr) * LDT + ks * 16 + lh * 8);
#pragma unroll
      for (int i = 0; i < 2; ++i)
#pragma unroll
        for (int j = 0; j < 2; ++j) acc[i][j] = __builtin_amdgcn_mfma_f32_32x32x16_bf16(a[i], b[j], acc[i][j], 0, 0, 0);
    }
  }
  __syncthreads();
#pragma unroll
  for (int i = 0; i < 2; ++i)
#pragma unroll
    for (int j = 0; j < 2; ++j)
#pragma unroll
      for (int r = 0; r < 16; ++r) {
        const int row = wm * 64 + i * 32 + (r & 3) + 8 * (r >> 2) + 4 * lh, col = wn * 64 + j * 32 + lr;
        Cs[row * LDC + col] = acc[i][j][r];
      }
  __syncthreads();
  epi(Cs, m0, n0);
}


template <class AL, class EPI>
DI void gemm_wide(const AL& al, const bf16_t* __restrict__ Bt, int K, int m0, int n0, int nhalf, char* smem, const EPI& epi) {
  bf16_t* As = (bf16_t*)smem;
  bf16_t* Bs = As + 128 * LDT;
  float* Cs = (float*)smem;
  const int tid = TIDX(), lane = tid & 63, wave = tid >> 6, wm = wave >> 1, wn = wave & 1;
  const int lr = lane & 31, lh = lane >> 5;
  f32x16 acc[2][4];
#pragma unroll
  for (int i = 0; i < 2; ++i)
#pragma unroll
    for (int j = 0; j < 4; ++j)
#pragma unroll
      for (int r = 0; r < 16; ++r) acc[i][j][r] = 0.f;
  u32x4 ra[4], rb[8];
  const int nkt = K >> 6;
#pragma unroll
  for (int i = 0; i < 8; ++i) {
    const int c = tid + 256 * i, row = c >> 3, kc = (c & 7) * 8;
    if (i < 4) ra[i] = al.load(m0 + row, kc);
    rb[i] = *(const u32x4*)(Bt + (size_t)(n0 + row) * K + kc);
  }
#pragma unroll 1
  for (int kt = 0; kt < nkt; ++kt) {
    __syncthreads();
#pragma unroll
    for (int i = 0; i < 8; ++i) {
      const int c = tid + 256 * i, row = c >> 3, kc = (c & 7) * 8;
      if (i < 4) *(u32x4*)(As + row * LDT + kc) = ra[i];
      *(u32x4*)(Bs + row * LDT + kc) = rb[i];
    }
    __syncthreads();
    if (kt + 1 < nkt) {
      const int k0 = (kt + 1) << 6;
#pragma unroll
      for (int i = 0; i < 8; ++i) {
        const int c = tid + 256 * i, row = c >> 3, kc = (c & 7) * 8;
        if (i < 4) ra[i] = al.load(m0 + row, k0 + kc);
        rb[i] = *(const u32x4*)(Bt + (size_t)(n0 + row) * K + k0 + kc);
      }
    }
    {
      bf16x8 a[2][2], b[2][4];
#pragma unroll
      for (int i = 0; i < 2; ++i) a[0][i] = *(const bf16x8*)(As + (wm * 64 + i * 32 + lr) * LDT + lh * 8);
#pragma unroll
      for (int j = 0; j < 4; ++j) b[0][j] = *(const bf16x8*)(Bs + (wn * 128 + j * 32 + lr) * LDT + lh * 8);
#pragma unroll
      for (int ks = 0; ks < 4; ++ks) {
        if (ks + 1 < 4) {
#pragma unroll
          for (int i = 0; i < 2; ++i) a[(ks + 1) & 1][i] = *(const bf16x8*)(As + (wm * 64 + i * 32 + lr) * LDT + (ks + 1) * 16 + lh * 8);
#pragma unroll
          for (int j = 0; j < 4; ++j) b[(ks + 1) & 1][j] = *(const bf16x8*)(Bs + (wn * 128 + j * 32 + lr) * LDT + (ks + 1) * 16 + lh * 8);
        }
#pragma unroll
        for (int i = 0; i < 2; ++i)
#pragma unroll
          for (int j = 0; j < 4; ++j) acc[i][j] = __builtin_amdgcn_mfma_f32_32x32x16_bf16(a[ks & 1][i], b[ks & 1][j], acc[i][j], 0, 0, 0);
        if (ks + 1 < 4) {
#pragma unroll
          for (int g = 0; g < 6; ++g) {
            __builtin_amdgcn_sched_group_barrier(0x100, 1, 0);
            __builtin_amdgcn_sched_group_barrier(0x008, 1, 0);
          }
          __builtin_amdgcn_sched_group_barrier(0x008, 2, 0);
        } else {
          __builtin_amdgcn_sched_group_barrier(0x008, 8, 0);
        }
      }
    }
  }
#pragma unroll
  for (int half = 0; half < 2; ++half) {
    __syncthreads();
    if (wn == half) {
#pragma unroll
      for (int i = 0; i < 2; ++i)
#pragma unroll
        for (int j = 0; j < 4; ++j)
#pragma unroll
          for (int r = 0; r < 16; ++r) {
            const int row = wm * 64 + i * 32 + (r & 3) + 8 * (r >> 2) + 4 * lh, col = j * 32 + lr;
            Cs[row * LDC + col] = acc[i][j][r];
          }
    }
    __syncthreads();
    if (half < nhalf) epi(Cs, m0, n0 + 128 * half);
  }
}

struct EpiInproj {
  const P& p;
  DI void operator()(const float* Cs, int m0, int n0) const {
    const int nt = n0 >> 7, tid = TIDX();
#pragma unroll 1
    for (int pass = 0; pass < 8; ++pass) {
      const int row = pass * 16 + (tid >> 4), c8 = (tid & 15) * 8;
      const size_t tok = (size_t)(m0 + row);
      const int pos = (int)(tok & 8191);
      const float* cr = Cs + row * LDC;
      float v[8];
      if (nt < 4) {
#pragma unroll
        for (int e = 0; e < 8; ++e) v[e] = cr[c8 + e];
        *(uint4*)(p.u_ssm + tok * 512 + nt * 128 + c8) = pack8(v);
      } else if (nt < 14) {
        const float2* rt = p.rope128 + pos * 64;
        if (c8 < 64) {
#pragma unroll
          for (int e = 0; e < 8; ++e) { const int c = c8 + e; const float2 cs = rt[c]; v[e] = cr[c] * cs.x - cr[c + 64] * cs.y; }
        } else {
#pragma unroll
          for (int e = 0; e < 8; ++e) { const int c = c8 + e, cc = c - 64; const float2 cs = rt[cc]; v[e] = cr[c] * cs.x + cr[cc] * cs.y; }
        }
        if (nt < 12) *(uint4*)(p.q + tok * 1024 + (nt - 4) * 128 + c8) = pack8(v);
        else *(uint2*)(p.k8 + tok * 256 + (nt - 12) * 128 + c8) = pack8_fp8(v);
      } else if (nt < 16) {
#pragma unroll
        for (int e = 0; e < 8; ++e) v[e] = cr[c8 + e];
        *(uint2*)(p.v8 + tok * 256 + (nt - 14) * 128 + c8) = pack8_fp8(v);
      } else if (nt < 20 || (nt == 20 && c8 < 64)) {
        const float2* rt = p.rope64 + pos * 32;
        const int cl = c8 & 63;
        if (cl < 32) {
#pragma unroll
          for (int e = 0; e < 8; ++e) { const int c = c8 + e; const float2 cs = rt[cl + e]; v[e] = cr[c] * cs.x - cr[c + 32] * cs.y; }
        } else {
#pragma unroll
          for (int e = 0; e < 8; ++e) { const int c = c8 + e; const float2 cs = rt[cl + e - 32]; v[e] = cr[c] * cs.x + cr[c - 32] * cs.y; }
        }
        bf16_t* dst = (nt < 20) ? (p.qidx + tok * 512 + (nt - 16) * 128 + c8) : (p.kidx + tok * 64 + c8);
        *(uint4*)dst = pack8(v);
      } else if (nt == 20) {
        if (c8 == 64) {
          float4 w0, w1;
          w0.x = cr[64] * IDX_SCALE; w0.y = cr[65] * IDX_SCALE; w0.z = cr[66] * IDX_SCALE; w0.w = cr[67] * IDX_SCALE;
          w1.x = cr[68] * IDX_SCALE; w1.y = cr[69] * IDX_SCALE; w1.z = cr[70] * IDX_SCALE; w1.w = cr[71] * IDX_SCALE;
          *(float4*)(p.widx + tok * 8) = w0; *(float4*)(p.widx + tok * 8 + 4) = w1;
        }
      } else {
#pragma unroll
        for (int e = 0; e < 8; ++e) v[e] = sigm(cr[c8 + e]);
        bf16_t* dst = (nt < 29) ? (p.sg_s + tok * 1024 + (nt - 21) * 128 + c8) : (p.sg_a + tok * 1024 + (nt - 29) * 128 + c8);
        *(uint4*)dst = pack8(v);
      }
    }
  }
};

struct EpiGlu {
  const P& p; const float* bglu;
  DI void operator()(const float* Cs, int m0, int n0) const {
    const int tid = TIDX(), c8 = (tid & 15) * 8, r0 = tid >> 4;
    u32x4 yr[8];
#pragma unroll
    for (int pass = 0; pass < 8; ++pass) yr[pass] = *(const u32x4*)(p.y_pre + (size_t)(m0 + pass * 16 + r0) * 512 + n0 + c8);
    float bg[8];
#pragma unroll
    for (int e = 0; e < 8; ++e) bg[e] = bglu[n0 + c8 + e];
#pragma unroll
    for (int pass = 0; pass < 8; ++pass) {
      const int row = pass * 16 + r0;
      const float* cr = Cs + row * LDC + c8;
      float v[8];
#pragma unroll
      for (int e = 0; e < 8; ++e) {
        const unsigned w = yr[pass][e >> 1];
        const float y = __uint_as_float((e & 1) ? (w & 0xffff0000u) : (w << 16));
        v[e] = y * sigm(cr[e] + bg[e]);
      }
      *(uint4*)(p.y_ssm + (size_t)(m0 + row) * 512 + n0 + c8) = pack8(v);
    }
  }
};

struct EpiMerge1 {
  const P& p;
  DI void operator()(const float* Cs, int m0, int n0) const {
    const int tid = TIDX(), c8 = (tid & 15) * 8, r0 = tid >> 4;
    u32x4 gr[8];
#pragma unroll
    for (int pass = 0; pass < 8; ++pass) gr[pass] = *(const u32x4*)(p.sg_s + (size_t)(m0 + pass * 16 + r0) * 1024 + n0 + c8);
#pragma unroll
    for (int pass = 0; pass < 8; ++pass) {
      const int row = pass * 16 + r0;
      const float* cr = Cs + row * LDC + c8;
      float v[8];
#pragma unroll
      for (int e = 0; e < 8; ++e) {
        const unsigned w = gr[pass][e >> 1];
        const float g = __uint_as_float((e & 1) ? (w & 0xffff0000u) : (w << 16));
        v[e] = g * cr[e];
      }
      *(uint4*)(p.sg_s + (size_t)(m0 + row) * 1024 + n0 + c8) = pack8(v);
    }
  }
};
struct EpiMerge2 {
  const P& p;
  DI void operator()(const float* Cs, int m0, int n0) const {
    const int tid = TIDX(), c8 = (tid & 15) * 8, r0 = tid >> 4;
    u32x4 gr[8], pr[8];
#pragma unroll
    for (int pass = 0; pass < 8; ++pass) {
      gr[pass] = *(const u32x4*)(p.sg_a + (size_t)(m0 + pass * 16 + r0) * 1024 + n0 + c8);
      pr[pass] = *(const u32x4*)(p.sg_s + (size_t)(m0 + pass * 16 + r0) * 1024 + n0 + c8);
    }
#pragma unroll
    for (int pass = 0; pass < 8; ++pass) {
      const int row = pass * 16 + r0;
      const float* cr = Cs + row * LDC + c8;
      float v[8];
#pragma unroll
      for (int e = 0; e < 8; ++e) {
        const unsigned wg = gr[pass][e >> 1], wp = pr[pass][e >> 1];
        const float g = __uint_as_float((e & 1) ? (wg & 0xffff0000u) : (wg << 16));
        const float pa = __uint_as_float((e & 1) ? (wp & 0xffff0000u) : (wp << 16));
        v[e] = pa + g * cr[e];
      }
      *(uint4*)(p.sg_s + (size_t)(m0 + row) * 1024 + n0 + c8) = pack8(v);
    }
  }
};
struct EpiResid {
  const float* xin; const float* gt; float* dst;
  DI void operator()(const float* Cs, int m0, int n0) const {
    const int tid = TIDX(), c8 = (tid & 15) * 8, r0 = tid >> 4;
    const int b = m0 >> 13;
    f32x4 xa[8], xb[8];
#pragma unroll
    for (int pass = 0; pass < 8; ++pass) {
      const f32x4* xs = (const f32x4*)(xin + (size_t)(m0 + pass * 16 + r0) * 1024 + n0 + c8);
      xa[pass] = xs[0]; xb[pass] = xs[1];
    }
    const f32x4* gs = (const f32x4*)(gt + b * 6144 + n0 + c8);
    const f32x4 g0 = gs[0], g1 = gs[1];
#pragma unroll
    for (int pass = 0; pass < 8; ++pass) {
      const int row = pass * 16 + r0;
      const float* cr = Cs + row * LDC + c8;
      f32x4 o0, o1;
#pragma unroll
      for (int e = 0; e < 4; ++e) { o0[e] = ALPHA * xa[pass][e] + (1.f + g0[e]) * cr[e]; o1[e] = ALPHA * xb[pass][e] + (1.f + g1[e]) * cr[4 + e]; }
      f32x4* d = (f32x4*)(dst + (size_t)(m0 + row) * 1024 + n0 + c8);
      d[0] = o0; d[1] = o1;
    }
  }
};
struct EpiGateUp {
  const P& p;
  DI void operator()(const float* Cs, int m0, int n0) const {
    const int tid = TIDX(), j = n0 >> 7;
#pragma unroll 1
    for (int pass = 0; pass < 4; ++pass) {
      const int row = pass * 32 + (tid >> 3), c8 = (tid & 7) * 8;
      const size_t tok = (size_t)(m0 + row);
      const float* cr = Cs + row * LDC + c8;
      float v[8];
#pragma unroll
      for (int e = 0; e < 8; ++e) { const float a = cr[e], bb = cr[64 + e]; v[e] = a * sigm(a) * bb; }
      *(uint4*)(p.act + tok * DFF + j * 64 + c8) = pack8(v);
    }
  }
};

DI int colmap(int mode, int n) {
  if (mode == 0) return n;
  if (mode == 1) return n < 2632 ? n : (n < 2688 ? -1 : (n < 4736 ? n - 56 : -1));
  const int j = n >> 7, r = n & 127;
  return r < 64 ? (64 * j + r) : (2816 + 64 * j + (r - 64));
}
DI void transpose_item(const float* __restrict__ src, int K, int Ns, bf16_t* __restrict__ dst, int mode, int item, char* smem) {
  float* T = (float*)smem;
  const int nkt = K >> 6, kt = item % nkt, nt = item / nkt, k0 = kt * 64, n0 = nt * 64, tid = TIDX();
  __syncthreads();
  {
    const int n = n0 + (tid & 63), sc = colmap(mode, n);
#pragma unroll 4
    for (int rr = 0; rr < 16; ++rr) {
      const int r = rr * 4 + (tid >> 6);
      T[r * 65 + (tid & 63)] = sc >= 0 ? src[(size_t)(k0 + r) * Ns + sc] : 0.f;
    }
  }
  __syncthreads();
#pragma unroll 4
  for (int rr = 0; rr < 16; ++rr) {
    const int nn = rr * 4 + (tid >> 6);
    dst[(size_t)(n0 + nn) * K + k0 + (tid & 63)] = f2bf(T[(tid & 63) * 65 + nn]);
  }
}

constexpr int TR_IN = 76 * 16, TR_GLU = 64, TR_PSSM = 16 * 8, TR_PATTN = 256, TR_OUT = 256, TR_GU = 88 * 16, TR_DOWN = 16 * 44;
constexpr int TR_LAYER = TR_IN + TR_GLU + TR_PSSM + TR_PATTN + TR_OUT + TR_GU + TR_DOWN;
constexpr int N_TR = 2 * TR_LAYER, N_COND = 2 * 192, N_ROPE = 8192 / 8, N_SSMT = (2 * 32 * 64) / 256;
constexpr int N_PRO = N_TR + N_COND + N_ROPE + N_SSMT;

DI void prologue_item(const P& p, int item, char* smem) {
  const int tid = TIDX();
  if (item < N_TR) {
    const int l = item / TR_LAYER; int it = item % TR_LAYER;
    bf16_t* wl = p.wT + (size_t)l * WO_LAYER;
    if (it < TR_IN) { transpose_item(p.w_in + (size_t)l * 1024 * 4680, 1024, 4680, wl + WO_IN, 1, it, smem); return; } it -= TR_IN;
    if (it < TR_GLU) { transpose_item(p.w_glu + (size_t)l * 512 * 512, 512, 512, wl + WO_GLU, 0, it, smem); return; } it -= TR_GLU;
    if (it < TR_PSSM) { transpose_item(p.p_ssm + (size_t)l * 512 * 1024, 512, 1024, wl + WO_PSSM, 0, it, smem); return; } it -= TR_PSSM;
    if (it < TR_PATTN) { transpose_item(p.p_attn + (size_t)l * 1024 * 1024, 1024, 1024, wl + WO_PATTN, 0, it, smem); return; } it -= TR_PATTN;
    if (it < TR_OUT) { transpose_item(p.w_out + (size_t)l * 1024 * 1024, 1024, 1024, wl + WO_OUT, 0, it, smem); return; } it -= TR_OUT;
    if (it < TR_GU) { transpose_item(p.w_gu + (size_t)l * 1024 * 5632, 1024, 5632, wl + WO_GU, 2, it, smem); return; } it -= TR_GU;
    transpose_item(p.w_down + (size_t)l * DFF * 1024, DFF, 1024, wl + WO_DOWN, 0, it, smem); return;
  }
  item -= N_TR;
  if (item < N_COND) {
    const int l = item / 192, n0 = (item % 192) * 32;
    float* sc = (float*)smem;
    float* red = sc + 8192;
    __syncthreads();
    for (int i = tid; i < 8192; i += 256) { const float cv = p.c[i]; sc[i] = cv * sigm(cv); }
    __syncthreads();
    const int nn = tid & 31, kc = tid >> 5;
    float acc[8];
#pragma unroll
    for (int b = 0; b < 8; ++b) acc[b] = 0.f;
    const float* wp = p.w_cond + ((size_t)l * 1024 + kc * 128) * 6144 + n0 + nn;
    for (int k = 0; k < 128; ++k) {
      const float w = wp[(size_t)k * 6144];
#pragma unroll
      for (int b = 0; b < 8; ++b) acc[b] += sc[b * 1024 + kc * 128 + k] * w;
    }
#pragma unroll
    for (int b = 0; b < 8; ++b) red[(kc * 8 + b) * 32 + nn] = acc[b];
    __syncthreads();
    {
      const int b = tid >> 5;
      float s = 0.f;
#pragma unroll
      for (int q = 0; q < 8; ++q) s += red[(q * 8 + b) * 32 + nn];
      p.mod[((size_t)l * 8 + b) * 6144 + n0 + nn] = s + p.b_cond[l * 6144 + n0 + nn];
    }
    return;
  }
  item -= N_COND;
  if (item < N_ROPE) {
#pragma unroll 1
    for (int k = 0; k < 3; ++k) {
      const int e = tid + 256 * k;
      const int pos = item * 8 + e / 96, j = e % 96;
      if (j < 64) {
        const float inv = (float)pow(10000.0, -(double)j / 64.0);
        const float ang = (float)pos * inv;
        p.rope128[pos * 64 + j] = make_float2((float)cos((double)ang), (float)sin((double)ang));
      } else {
        const int i = j - 64;
        const float inv = (float)pow(10000.0, -(double)i / 32.0);
        const float ang = (float)pos * inv;
        p.rope64[pos * 32 + i] = make_float2((float)cos((double)ang), (float)sin((double)ang));
      }
    }
    return;
  }
  item -= N_ROPE;
  {
    const int idx = item * 256 + tid;
    const int lg = idx >> 6;
    const double dt = exp((double)p.log_dt[lg]);
    const double lr = p.lam_re[idx], li = p.lam_im[idx];
    const double mag = exp(lr * dt), ar = mag * cos(li * dt), ai = mag * sin(li * dt);
    const double mag128 = exp(lr * dt * 128.0), ar128 = mag128 * cos(li * dt * 128.0), ai128 = mag128 * sin(li * dt * 128.0);
    const double den = lr * lr + li * li, nr = ar - 1.0;
    const double fr = (nr * lr + ai * li) / den, fi = (ai * lr - nr * li) / den;
    p.ssmA[idx] = make_float4((float)ar, (float)ai, (float)ar128, (float)ai128);
    for (int i = 0; i < 16; ++i) {
      const double br = p.b_re[(size_t)idx * 16 + i], bi = p.b_im[(size_t)idx * 16 + i];
      p.ssmB[(size_t)idx * 16 + i] = make_float2((float)(fr * br - fi * bi), (float)(fr * bi + fi * br));
    }
  }
}

template <bool FULL>
DI void ssm_item(const P& p, int l, int item, char* smem) {
  const int tid = TIDX(), lane = tid & 63, wave = tid >> 6;
  const int b = item >> 9, c = (item >> 3) & 63, g = (item & 7) * 4 + wave;
  float* H = (float*)smem + wave * (16 * 132 + 256);
  float* us = H + 16 * 132;
  const int lg = l * 32 + g;
  const float4 a4 = p.ssmA[lg * 64 + lane];
  const float ar = a4.x, ai = a4.y;
  float bbr[16], bbi[16];
  {
    const float4* bp = (const float4*)(p.ssmB + ((size_t)lg * 64 + lane) * 16);
#pragma unroll
    for (int i = 0; i < 8; ++i) { const float4 t = bp[i]; bbr[2 * i] = t.x; bbi[2 * i] = t.y; bbr[2 * i + 1] = t.z; bbi[2 * i + 1] = t.w; }
  }
  float hr = 0.f, hi = 0.f;
  const int ch = lane & 15, quad = lane >> 4;
  float creg[32];
  float dsk = 0.f;
  if (FULL) {
    const float2* Ep = p.E + ((size_t)(b * 32 + g) * 64) * 64 + lane;
    for (int cc = 0; cc < c; ++cc) {
      const float2 e = Ep[cc * 64];
      const float nhr = a4.z * hr - a4.w * hi + e.x, nhi = a4.z * hi + a4.w * hr + e.y;
      hr = nhr; hi = nhi;
    }
    const float* cp = (quad < 2 ? p.c_re : p.c_im) + ((size_t)lg * 16 + ch) * 64 + (quad & 1) * 32;
    const float sgn = quad < 2 ? 1.f : -1.f;
#pragma unroll
    for (int i = 0; i < 8; ++i) { const float4 t = ((const float4*)cp)[i]; creg[4 * i] = sgn * t.x; creg[4 * i + 1] = sgn * t.y; creg[4 * i + 2] = sgn * t.z; creg[4 * i + 3] = sgn * t.w; }
    dsk = p.d_skip[l * 512 + g * 16 + ch];
  }
  const size_t tok0 = (size_t)b * SEQ + c * 128;
  const int tt = lane >> 2, part = lane & 3;
  uint2 raw = *(const uint2*)(p.u_ssm + (tok0 + tt) * 512 + g * 16 + part * 4);
#pragma unroll 1
  for (int s = 0; s < 8; ++s) {
    float4 uf;
    uf.x = __uint_as_float(raw.x << 16); uf.y = __uint_as_float(raw.x & 0xffff0000u);
    uf.z = __uint_as_float(raw.y << 16); uf.w = __uint_as_float(raw.y & 0xffff0000u);
    __builtin_amdgcn_wave_barrier();
    *(float4*)(us + tt * 16 + part * 4) = uf;
    __builtin_amdgcn_wave_barrier();
    if (s + 1 < 8) raw = *(const uint2*)(p.u_ssm + (tok0 + (s + 1) * 16 + tt) * 512 + g * 16 + part * 4);
#pragma unroll 4
    for (int t = 0; t < 16; ++t) {
      const float4* up = (const float4*)(us + t * 16);
      const float4 u0 = up[0], u1 = up[1], u2 = up[2], u3 = up[3];
      const float uu[16] = {u0.x, u0.y, u0.z, u0.w, u1.x, u1.y, u1.z, u1.w, u2.x, u2.y, u2.z, u2.w, u3.x, u3.y, u3.z, u3.w};
      float br = 0.f, bi = 0.f;
#pragma unroll
      for (int i = 0; i < 16; ++i) { br = fmaf(bbr[i], uu[i], br); bi = fmaf(bbi[i], uu[i], bi); }
      const float nhr = ar * hr - ai * hi + br, nhi = ar * hi + ai * hr + bi;
      hr = nhr; hi = nhi;
      if (FULL) { H[t * 132 + lane] = hr; H[t * 132 + 64 + lane] = hi; }
    }
    if (FULL) {
      __builtin_amdgcn_wave_barrier();
      f32x4 acc = {0.f, 0.f, 0.f, 0.f};
      const float* hp = H + ch * 132 + quad * 32;
#pragma unroll
      for (int i = 0; i < 8; ++i) {
        const float4 hv = *(const float4*)(hp + 4 * i);
        acc = __builtin_amdgcn_mfma_f32_16x16x4f32(hv.x, creg[4 * i], acc, 0, 0, 0);
        acc = __builtin_amdgcn_mfma_f32_16x16x4f32(hv.y, creg[4 * i + 1], acc, 0, 0, 0);
        acc = __builtin_amdgcn_mfma_f32_16x16x4f32(hv.z, creg[4 * i + 2], acc, 0, 0, 0);
        acc = __builtin_amdgcn_mfma_f32_16x16x4f32(hv.w, creg[4 * i + 3], acc, 0, 0, 0);
      }
#pragma unroll
      for (int r = 0; r < 4; ++r) {
        const int tl = quad * 4 + r;
        float y = acc[r] + dsk * us[tl * 16 + ch];
        const float y3 = y * y * y;
        y = y * sigm(1.5957691216057308f * (y + 0.044715f * y3));
        p.y_pre[(tok0 + s * 16 + tl) * 512 + g * 16 + ch] = f2bf(y);
      }
    }
  }
  if (!FULL) p.E[((size_t)(b * 32 + g) * 64 + c) * 64 + lane] = make_float2(hr, hi);
}

DI unsigned mono(float f) { const unsigned u = __float_as_uint(f); return (u & 0x80000000u) ? ~u : (u | 0x80000000u); }

DI void select_item(const P& p, int b, int quad4, int bid, char* smem) {
  const int t0 = quad4 * 4;
  if (t0 < 256) return;
  const int tid = TIDX(), lane = tid & 63, wave = tid >> 6;
  unsigned* hist = (unsigned*)smem + wave * 256;
  unsigned* candi = (unsigned*)smem + 1024 + wave * 512;
  unsigned* candk = candi + 256;
  unsigned short* sc16 = (unsigned short*)((unsigned*)smem + 3072);
  unsigned* scr = p.scr + (size_t)bid * 4 * 8192;
  const size_t tok0 = (size_t)b * SEQ + t0;
  __syncthreads();
  {
    const int r = lane & 31, h = lane >> 5;
    bf16x8 a[4];
    {
      const bf16_t* qp = p.qidx + (tok0 + (r >> 3)) * 512 + (r & 7) * 64 + h * 8;
#pragma unroll
      for (int s = 0; s < 4; ++s) a[s] = *(const bf16x8*)(qp + s * 16);
    }
    float4 w[4];
#pragma unroll
    for (int q = 0; q < 4; ++q) w[q] = *(const float4*)(p.widx + (tok0 + q) * 8 + h * 4);
    const int ntile = (t0 + 4 + 31) >> 5;
    const bf16_t* kbase = p.kidx + ((size_t)b * SEQ) * 64 + h * 8;
    const int nit = (ntile - wave + 3) >> 2;
#pragma unroll 1
    for (int i0 = 0; i0 < nit; i0 += 4) {
      bf16x8 bf[4][4];
#pragma unroll
      for (int u = 0; u < 4; ++u) {
        int kt = wave + 4 * (i0 + u); kt = kt < ntile ? kt : ntile - 1;
        const bf16_t* kp = kbase + (size_t)(kt * 32 + r) * 64;
#pragma unroll
        for (int s = 0; s < 4; ++s) bf[u][s] = *(const bf16x8*)(kp + s * 16);
      }
#pragma unroll
      for (int u = 0; u < 4; ++u) {
        const int key = (wave + 4 * (i0 + u)) * 32 + r;
        f32x16 acc;
#pragma unroll
        for (int i = 0; i < 16; ++i) acc[i] = 0.f;
#pragma unroll
        for (int s = 0; s < 4; ++s) acc = __builtin_amdgcn_mfma_f32_32x32x16_bf16(a[s], bf[u][s], acc, 0, 0, 0);
        float tot[4];
#pragma unroll
        for (int q = 0; q < 4; ++q) {
          float sq = 0.f;
          sq = fmaf(fmaxf(acc[4 * q + 0], 0.f), w[q].x, sq); sq = fmaf(fmaxf(acc[4 * q + 1], 0.f), w[q].y, sq);
          sq = fmaf(fmaxf(acc[4 * q + 2], 0.f), w[q].z, sq); sq = fmaf(fmaxf(acc[4 * q + 3], 0.f), w[q].w, sq);
          tot[q] = sq + __shfl_xor(sq, 32);
        }
        if (i0 + u < nit) {
          const unsigned m0 = mono(h == 0 ? tot[0] : tot[2]), m1 = mono(h == 0 ? tot[1] : tot[3]);
          const int q0 = h * 2;
          sc16[q0 * 8192 + key] = (unsigned short)(m0 >> 16); sc16[(q0 + 1) * 8192 + key] = (unsigned short)(m1 >> 16);
          __builtin_nontemporal_store(m0, scr + q0 * 8192 + key); __builtin_nontemporal_store(m1, scr + (q0 + 1) * 8192 + key);
        }
      }
    }
  }
  __syncthreads();
  {
    const int qi = wave, n = t0 + qi + 1;
    const unsigned short* s = sc16 + qi * 8192;
    const unsigned* s32 = (const unsigned*)s;
    unsigned prefix = 0, pmask = 0, need = 256, eq_total = 0;
#pragma unroll 1
    for (int pass = 0; pass < 2; ++pass) {
      const int shift = 8 - 8 * pass;
#pragma unroll
      for (int k = 0; k < 4; ++k) hist[lane + 64 * k] = 0;
      __builtin_amdgcn_wave_barrier();
      for (int e2 = lane; 2 * e2 < n; e2 += 64) {
        const unsigned wv = s32[e2];
        const unsigned k0 = wv & 0xffffu, k1 = wv >> 16;
        if ((k0 & pmask) == prefix) atomicAdd(&hist[(k0 >> shift) & 255], 1u);
        if (2 * e2 + 1 < n && (k1 & pmask) == prefix) atomicAdd(&hist[(k1 >> shift) & 255], 1u);
      }
      __builtin_amdgcn_wave_barrier();
      const uint4 h4 = *(const uint4*)(hist + 4 * lane);
      const unsigned sum = h4.x + h4.y + h4.z + h4.w;
      unsigned incl = sum;
#pragma unroll
      for (int off = 1; off < 64; off <<= 1) { const unsigned v = __shfl_down(incl, off); if (lane + off < 64) incl += v; }
      unsigned above = incl - sum;
      const bool found = above < need && need <= incl;
      unsigned dig = 0, cnt = 0;
      if (found) {
        if (above + h4.w >= need) { dig = 3; cnt = h4.w; }
        else { above += h4.w;
          if (above + h4.z >= need) { dig = 2; cnt = h4.z; }
          else { above += h4.z;
            if (above + h4.y >= need) { dig = 1; cnt = h4.y; }
            else { above += h4.y; dig = 0; cnt = h4.x; } } }
        dig += 4 * lane;
      }
      const unsigned long long fb = __ballot(found);
      const int fl = fb ? (__ffsll((long long)fb) - 1) : 0;
      const unsigned dsel = __shfl(dig, fl), nneed = __shfl(need - above, fl), ncnt = __shfl(cnt, fl);
      prefix |= dsel << shift; pmask |= 0xffu << shift; need = nneed; eq_total = ncnt;
      __builtin_amdgcn_wave_barrier();
    }
    const unsigned thr = prefix, ngt = 256 - need;
    unsigned short* dst = p.sel + (tok0 + qi) * 256;
    const unsigned long long lm = (1ull << lane) - 1ull;
    unsigned og = 0, oe = 0;
    for (int base = 0; base < n; base += 64) {
      const int e = base + lane;
      const unsigned u = e < n ? (unsigned)s[e] : 0u;
      const bool isg = e < n && u > thr, ise = e < n && u == thr;
      const unsigned long long bg = __ballot(isg), be = __ballot(ise);
      if (isg) { const unsigned pos = og + __popcll(bg & lm); if (pos < 256u) dst[pos] = (unsigned short)e; }
      if (ise) { const unsigned rr = oe + __popcll(be & lm); if (rr < 256u) candi[rr] = (unsigned)e; }
      og += __popcll(bg); oe += __popcll(be);
    }
    __builtin_amdgcn_wave_barrier();
    const unsigned c = eq_total < 256u ? eq_total : 256u;
    if (eq_total == need) {
      for (unsigned i = lane; i < c; i += 64) if (ngt + i < 256u) dst[ngt + i] = (unsigned short)candi[i];
    } else {
      for (unsigned i = lane; i < c; i += 64) candk[i] = __hip_atomic_load(scr + qi * 8192 + candi[i], __ATOMIC_RELAXED, __HIP_MEMORY_SCOPE_AGENT);
      __builtin_amdgcn_wave_barrier();
      for (unsigned i = lane; i < c; i += 64) {
        const unsigned ki = candk[i];
        unsigned rank = 0;
        for (unsigned j2 = 0; j2 < c; ++j2) { const unsigned kj = candk[j2]; rank += (kj > ki || (kj == ki && j2 < i)) ? 1u : 0u; }
        if (rank < need && ngt + rank < 256u) dst[ngt + rank] = (unsigned short)candi[i];
      }
    }
  }
  __syncthreads();
}

struct AttnPre { uint2 sv; u32x4 tq[4]; };
DI void attn_prefetch(const P& p, int b, int kvh, int quad4, AttnPre& pre) {
  const int tid = TIDX(), lane = tid & 63, wave = tid >> 6;
  const int t = quad4 * 4 + wave;
  const size_t tok = (size_t)b * SEQ + t;
  const int r = lane & 15, quad = lane >> 4;
  pre.sv = make_uint2(0u, 0u);
  if (t >= 256) pre.sv = *(const uint2*)(p.sel + tok * 256 + lane * 4);
  const bf16_t* qp = p.q + tok * 1024 + (kvh * 4 + (r & 3)) * 128 + quad * 16;
#pragma unroll
  for (int s = 0; s < 4; ++s) pre.tq[s] = *(const u32x4*)(qp + (s >> 1) * 64 + (s & 1) * 8);
}
DI void attn_item(const P& p, int b, int kvh, int quad4, char* smem, const AttnPre& pre) {
  const int tid = TIDX(), lane = tid & 63, wave = tid >> 6;
  const int t = quad4 * 4 + wave;
  const size_t tok = (size_t)b * SEQ + t;
  float* L = (float*)smem + wave * (1024 + 256);
  int* idx = (int*)(L + 1024);
  const int cnt = t < 256 ? t + 1 : 256;
  __builtin_amdgcn_wave_barrier();
  if (t < 256) {
#pragma unroll
    for (int j = 0; j < 4; ++j) { const int n = lane + 64 * j; idx[n] = n < cnt ? n : 0; }
  } else {
    const uint2 sv = pre.sv;
    idx[lane * 4 + 0] = sv.x & 0xffff; idx[lane * 4 + 1] = sv.x >> 16; idx[lane * 4 + 2] = sv.y & 0xffff; idx[lane * 4 + 3] = sv.y >> 16;
  }
  const int r = lane & 15, quad = lane >> 4;
  long qa8[4];
  {
    const bf16_t* qp = p.q + tok * 1024 + (kvh * 4 + (r & 3)) * 128 + quad * 16;
#pragma unroll
    for (int s = 0; s < 4; ++s) {
      const u32x4 tq = pre.tq[s];
      float f[8];
#pragma unroll
      for (int e = 0; e < 4; ++e) { f[2 * e] = __uint_as_float(tq[e] << 16); f[2 * e + 1] = __uint_as_float(tq[e] & 0xffff0000u); }
      const uint2 pk = pack8_fp8(f);
      long v = (long)(((unsigned long long)pk.y << 32) | (unsigned long long)pk.x);
      if (r >= 4) v = 0;
      qa8[s] = v;
    }
  }
  __builtin_amdgcn_wave_barrier();
  const unsigned char* kb = p.k8 + ((size_t)b * SEQ) * 256 + kvh * 128 + quad * 16;
  int myidx[16];
#pragma unroll
  for (int kt = 0; kt < 16; ++kt) myidx[kt] = idx[kt * 16 + r];
#pragma unroll
  for (int kt0 = 0; kt0 < 16; kt0 += 8) {
    u32x4 kraw[8][2];
#pragma unroll
    for (int u = 0; u < 8; ++u) {
      const unsigned char* kp = kb + (size_t)myidx[kt0 + u] * 256;
      kraw[u][0] = *(const u32x4*)kp; kraw[u][1] = *(const u32x4*)(kp + 64);
    }
#pragma unroll
    for (int u = 0; u < 8; ++u) {
      const int n = (kt0 + u) * 16 + r;
      f32x4 acc = {0.f, 0.f, 0.f, 0.f};
#pragma unroll
      for (int S = 0; S < 2; ++S) {
        const long k0 = (long)(((unsigned long long)kraw[u][S][1] << 32) | (unsigned long long)kraw[u][S][0]);
        const long k1 = (long)(((unsigned long long)kraw[u][S][3] << 32) | (unsigned long long)kraw[u][S][2]);
        acc = __builtin_amdgcn_mfma_f32_16x16x32_fp8_fp8(qa8[2 * S], k0, acc, 0, 0, 0);
        acc = __builtin_amdgcn_mfma_f32_16x16x32_fp8_fp8(qa8[2 * S + 1], k1, acc, 0, 0, 0);
      }
      if (quad == 0) {
        const bool ok = n < cnt;
#pragma unroll
        for (int h = 0; h < 4; ++h) L[h * 256 + n] = ok ? acc[h] * ATT_SCALE : -INFINITY;
      }
    }
  }
  __builtin_amdgcn_wave_barrier();
  float pr[4][4];
#pragma unroll
  for (int h = 0; h < 4; ++h) {
    float m = -INFINITY;
#pragma unroll
    for (int j = 0; j < 4; ++j) { pr[h][j] = L[h * 256 + lane + 64 * j]; m = fmaxf(m, pr[h][j]); }
#pragma unroll
    for (int off = 32; off >= 1; off >>= 1) m = fmaxf(m, __shfl_xor(m, off));
    float sum = 0.f;
#pragma unroll
    for (int j = 0; j < 4; ++j) { pr[h][j] = __expf(pr[h][j] - m); sum += pr[h][j]; }
#pragma unroll
    for (int off = 32; off >= 1; off >>= 1) sum += __shfl_xor(sum, off);
    const float inv = 1.f / sum;
#pragma unroll
    for (int j = 0; j < 4; ++j) pr[h][j] *= inv;
  }
  __builtin_amdgcn_wave_barrier();
#pragma unroll
  for (int j = 0; j < 4; ++j) *(float4*)(L + (lane + 64 * j) * 4) = make_float4(pr[0][j], pr[1][j], pr[2][j], pr[3][j]);
  __builtin_amdgcn_wave_barrier();
  float o[4][8];
#pragma unroll
  for (int h = 0; h < 4; ++h)
#pragma unroll
    for (int e = 0; e < 8; ++e) o[h][e] = 0.f;
  const unsigned char* vb = p.v8 + ((size_t)b * SEQ) * 256 + kvh * 128 + r * 8;
#pragma unroll 1
  for (int n0 = 0; n0 < 256; n0 += 64) {
    uint2 vv[16];
#pragma unroll
    for (int u = 0; u < 16; ++u) vv[u] = *(const uint2*)(vb + (size_t)idx[n0 + 4 * u + quad] * 256);
#pragma unroll
    for (int u = 0; u < 16; ++u) {
      const float4 p4 = *(const float4*)(L + (n0 + 4 * u + quad) * 4);
      const f32x2_t c0 = __builtin_amdgcn_cvt_pk_f32_fp8((int)vv[u].x, false), c1 = __builtin_amdgcn_cvt_pk_f32_fp8((int)vv[u].x, true);
      const f32x2_t c2 = __builtin_amdgcn_cvt_pk_f32_fp8((int)vv[u].y, false), c3 = __builtin_amdgcn_cvt_pk_f32_fp8((int)vv[u].y, true);
      const float vf[8] = {c0.x, c0.y, c1.x, c1.y, c2.x, c2.y, c3.x, c3.y};
#pragma unroll
      for (int e = 0; e < 8; ++e) {
        o[0][e] = fmaf(p4.x, vf[e], o[0][e]); o[1][e] = fmaf(p4.y, vf[e], o[1][e]);
        o[2][e] = fmaf(p4.z, vf[e], o[2][e]); o[3][e] = fmaf(p4.w, vf[e], o[3][e]);
      }
    }
  }
#pragma unroll
  for (int h = 0; h < 4; ++h)
#pragma unroll
    for (int e = 0; e < 8; ++e) { float v = o[h][e]; v += __shfl_xor(v, 16); v += __shfl_xor(v, 32); o[h][e] = v; }
  if (quad == 0) {
#pragma unroll
    for (int h = 0; h < 4; ++h) *(uint4*)(p.q + tok * 1024 + (kvh * 4 + h) * 128 + r * 8) = pack8(o[h]);
  }
}

template <int GRP>
DI void ln_items(float* X, const float* gam, const float* bet, bf16_t* u2, const float* sc, const float* sh, int item0) {
  const int tid = TIDX(), lane = tid & 63, wave = tid >> 6;
  f32x4 v[GRP][4];
#pragma unroll
  for (int g = 0; g < GRP; ++g) {
    const size_t tok = (size_t)(item0 + g) * 4 + wave;
#pragma unroll
    for (int j = 0; j < 4; ++j) v[g][j] = *(const f32x4*)(X + tok * 1024 + j * 256 + lane * 4);
  }
#pragma unroll
  for (int g = 0; g < GRP; ++g) {
    const size_t tok = (size_t)(item0 + g) * 4 + wave;
    const int b = (int)(tok >> 13);
    float s = 0.f;
#pragma unroll
    for (int j = 0; j < 4; ++j) s += v[g][j][0] + v[g][j][1] + v[g][j][2] + v[g][j][3];
#pragma unroll
    for (int off = 32; off >= 1; off >>= 1) s += __shfl_xor(s, off);
    const float mu = s * (1.f / 1024.f);
    float q = 0.f;
#pragma unroll
    for (int j = 0; j < 4; ++j)
#pragma unroll
      for (int e = 0; e < 4; ++e) { const float d = v[g][j][e] - mu; q += d * d; }
#pragma unroll
    for (int off = 32; off >= 1; off >>= 1) q += __shfl_xor(q, off);
    const float rstd = rsqrtf(q * (1.f / 1024.f) + 1e-5f);
#pragma unroll
    for (int j = 0; j < 4; ++j) {
      const int col = j * 256 + lane * 4;
      const f32x4 gg = *(const f32x4*)(gam + col), be = *(const f32x4*)(bet + col);
      f32x4 y;
#pragma unroll
      for (int e = 0; e < 4; ++e) y[e] = (v[g][j][e] - mu) * rstd * gg[e] + be[e];
      *(f32x4*)(X + tok * 1024 + col) = y;
      if (u2) {
        const f32x4 s4 = *(const f32x4*)(sc + b * 6144 + col), h4 = *(const f32x4*)(sh + b * 6144 + col);
        uint2 o;
        o.x = pack2(y[0] * (1.f + s4[0]) + h4[0], y[1] * (1.f + s4[1]) + h4[1]);
        o.y = pack2(y[2] * (1.f + s4[2]) + h4[2], y[3] * (1.f + s4[3]) + h4[3]);
        *(uint2*)(u2 + tok * 1024 + col) = o;
      }
    }
  }
}

enum { PH_PRO = 0, PH_U1, PH_INPROJ, PH_SEL, PH_SSMA, PH_ATTN, PH_SSMB, PH_CHA, PH_CHB, PH_COUNT };

DI void run_phase(const P& p, int ph, int l, int bid, int nblk, char* smem) {
  const float* modl = p.mod + (size_t)l * 8 * 6144;
  const bf16_t* wl = p.wT + (size_t)l * WO_LAYER;
  const float* xin = (l == 0) ? p.x : p.out;
  switch (ph) {
    case PH_PRO:
      for (int it = bid; it < N_PRO; it += nblk) prologue_item(p, it, smem);
      break;
    case PH_U1:
      for (int it = bid; it < NTOK / 2; it += nblk) {
        const size_t e0 = (size_t)it * 2048 + TIDX() * 8;
        const int b = (int)(e0 >> 23), col = (int)(e0 & 1023);
        const float4 x0 = *(const float4*)(xin + e0), x1 = *(const float4*)(xin + e0 + 4);
        const float4 s0 = *(const float4*)(modl + b * 6144 + 1024 + col), s1 = *(const float4*)(modl + b * 6144 + 1024 + col + 4);
        const float4 h0 = *(const float4*)(modl + b * 6144 + col), h1 = *(const float4*)(modl + b * 6144 + col + 4);
        uint4 r;
        r.x = pack2(x0.x * (1.f + s0.x) + h0.x, x0.y * (1.f + s0.y) + h0.y);
        r.y = pack2(x0.z * (1.f + s0.z) + h0.z, x0.w * (1.f + s0.w) + h0.w);
        r.z = pack2(x1.x * (1.f + s1.x) + h1.x, x1.y * (1.f + s1.y) + h1.y);
        r.w = pack2(x1.z * (1.f + s1.z) + h1.z, x1.w * (1.f + s1.w) + h1.w);
        *(uint4*)((bf16_t*)p.XA + e0) = r;
      }
      break;
    case PH_INPROJ: {
      ALoadBf16 al{(const bf16_t*)p.XA, 1024};
      EpiInproj epi{p};
      if ((nblk & 7) == 0) {
        const int x = bid & 7, j = bid >> 3, nj = nblk >> 3;
        for (int i = j; i < 64 * 19; i += nj) gemm_wide(al, wl + WO_IN, 1024, (x + 8 * (i / 19)) * 128, (i % 19) * 256, (i % 19) == 18 ? 1 : 2, smem, epi);
      } else {
        for (int it = bid; it < 512 * 19; it += nblk) gemm_wide(al, wl + WO_IN, 1024, (it / 19) * 128, (it % 19) * 256, (it % 19) == 18 ? 1 : 2, smem, epi);
      }
    } break;
    case PH_SEL:
      if ((nblk & 7) == 0) {
        const int b = bid & 7, j = bid >> 3, nj = nblk >> 3;
        for (int i = j; i < 2048; i += nj) select_item(p, b, 2047 - i, bid, smem);
      } else {
        for (int it = bid; it < 16384; it += nblk) select_item(p, it >> 11, 2047 - (it & 2047), bid, smem);
      }
      break;
    case PH_SSMA:
      for (int it = bid; it < 4096; it += nblk) ssm_item<false>(p, l, it, smem);
      break;
    case PH_ATTN:
      if ((nblk & 7) == 0) {
        const int b = bid & 7, j = bid >> 3, nj = nblk >> 3;
        AttnPre pa, pb;
        if (j < 4096) attn_prefetch(p, b, j >> 11, j & 2047, pa);
        for (int i = j; i < 4096; i += nj) {
          const int inext = i + nj;
          if (inext < 4096) attn_prefetch(p, b, inext >> 11, inext & 2047, pb);
          attn_item(p, b, i >> 11, i & 2047, smem, pa);
          pa = pb;
        }
      } else {
        for (int it = bid; it < 32768; it += nblk) { AttnPre pa; attn_prefetch(p, it >> 12, (it >> 11) & 1, it & 2047, pa); attn_item(p, it >> 12, (it >> 11) & 1, it & 2047, smem, pa); }
      }
      break;
    case PH_SSMB:
      for (int it = bid; it < 4096; it += nblk) ssm_item<true>(p, l, it, smem);
      break;
    case PH_CHA: {
      ALoadBf16 aglu{p.y_pre, 512}, a1{p.y_ssm, 512}, a2{p.q, 1024}, aout{p.sg_s, 1024};
      EpiGlu eglu{p, p.b_glu + l * 512};
      EpiMerge1 e1{p}; EpiMerge2 e2{p};
      EpiResid eres{xin, modl + 2048, p.XA};
#pragma unroll 1
      for (int m = bid; m < 512; m += nblk) {
        const int m0 = m * 128;
#pragma unroll 1
        for (int n = 0; n < 2; ++n) gemm_wide(aglu, wl + WO_GLU, 512, m0, n * 256, 2, smem, eglu);
        __syncthreads();
#pragma unroll 1
        for (int n = 0; n < 4; ++n) {
          gemm_wide(a1, wl + WO_PSSM, 512, m0, n * 256, 2, smem, e1);
          gemm_wide(a2, wl + WO_PATTN, 1024, m0, n * 256, 2, smem, e2);
        }
        __syncthreads();
#pragma unroll 1
        for (int n = 0; n < 4; ++n) gemm_wide(aout, wl + WO_OUT, 1024, m0, n * 256, 2, smem, eres);
        __syncthreads();
#pragma unroll 1
        for (int i = 0; i < 32; i += 4) ln_items<4>(p.XA, p.ln1_g + l * 1024, p.ln1_b + l * 1024, p.u2, modl + 4096, modl + 3072, m * 32 + i);
        __syncthreads();
      }
    } break;
    case PH_CHB: {
      ALoadBf16 agu{p.u2, 1024}, adn{p.act, DFF};
      EpiGateUp egu{p};
      EpiResid eres{p.XA, modl + 5120, p.out};
#pragma unroll 1
      for (int m = bid; m < 512; m += nblk) {
        const int m0 = m * 128;
#pragma unroll 1
        for (int n = 0; n < 22; ++n) gemm_wide(agu, wl + WO_GU, 1024, m0, ((n + (m & 3)) % 22) * 256, 2, smem, egu);
        __syncthreads();
#pragma unroll 1
        for (int n = 0; n < 4; ++n) gemm_wide(adn, wl + WO_DOWN, DFF, m0, n * 256, 2, smem, eres);
        __syncthreads();
#pragma unroll 1
        for (int i = 0; i < 32; i += 4) ln_items<4>(p.out, p.ln2_g + l * 1024, p.ln2_b + l * 1024, nullptr, nullptr, nullptr, m * 32 + i);
        __syncthreads();
      }
    } break;
  }
}

template <int PH> __global__ void __launch_bounds__(256, 2) k_phase(P p, int l) {
  extern __shared__ __attribute__((aligned(16))) char smem[];
  run_phase(p, PH, l, blockIdx.x, gridDim.x, smem);
}
template <int PH> static void launch_phase(const P& p, int l, int G, hipStream_t stream) {
  static bool attr = false;
  if (!attr) { attr = true; (void)hipFuncSetAttribute((const void*)k_phase<PH>, hipFuncAttributeMaxDynamicSharedMemorySize, LDS_BYTES); }
  hipLaunchKernelGGL((k_phase<PH>), dim3(G), dim3(256), LDS_BYTES, stream, p, l);
}

#if MEGA
__global__ void __launch_bounds__(256, 2) k_mega(P p) {
  extern __shared__ __attribute__((aligned(16))) char smem[];
  cg::grid_group grid = cg::this_grid();
  run_phase(p, PH_PRO, 0, blockIdx.x, gridDim.x, smem);
  grid.sync();
#pragma unroll 1
  for (int l = 0; l < 2; ++l) {
#pragma unroll 1
    for (int ph = PH_U1; ph < PH_COUNT; ++ph) {
      run_phase(p, ph, l, blockIdx.x, gridDim.x, smem);
      if (!(l == 1 && ph == PH_CHB)) grid.sync();
    }
  }
}
#endif


extern "C" void kernel_launch(void* const* d_in, const int* in_sizes, int n_in, void* d_out, int out_size, void* d_ws, size_t ws_size, hipStream_t stream) {
  constexpr size_t MiB = 1ull << 20;
  size_t off = 0;
  auto take = [&](size_t bytes) { size_t o = off; off += (bytes + 255) & ~(size_t)255; return o; };
  const size_t o_wT = take(2 * WO_LAYER * 2);
  const size_t o_rope128 = take(8192 * 64 * 8), o_rope64 = take(8192 * 32 * 8);
  const size_t o_ssmA = take(2 * 32 * 64 * 16), o_ssmB = take(2 * 32 * 64 * 16 * 8), o_mod = take(2 * 8 * 6144 * 4), o_E = take((size_t)8 * 32 * 64 * 64 * 8);
  const size_t o_XA = take((size_t)NTOK * 1024 * 4);
  const size_t o_sel = take((size_t)NTOK * 256 * 2);
  const size_t o_P = off;
  const size_t o_ussm = take((size_t)NTOK * 512 * 2), o_q = take((size_t)NTOK * 1024 * 2), o_k = take((size_t)NTOK * 256 * 2), o_v = take((size_t)NTOK * 256 * 2);
  const size_t o_qidx = take((size_t)NTOK * 512 * 2), o_kidx = take((size_t)NTOK * 64 * 2), o_widx = take((size_t)NTOK * 8 * 4);
  const size_t o_sgs = take((size_t)NTOK * 1024 * 2), o_sga = take((size_t)NTOK * 1024 * 2);
  const size_t o_scr = take((size_t)512 * 4 * 8192 * 4);
  const size_t total = off;
  static int state = 0, grid_blocks = 0;
  if (state == 0) {
    state = 1;
    if (n_in != 24 || out_size != NTOK * 1024 || ws_size < total) {
      fprintf(stderr, "kernel_launch: unexpected sizes n_in %d out %d ws %zu (need %zu)\n", n_in, out_size, ws_size, total);
      state = -1;
    } else {
      int dev = 0, cus = 0, per_cu = 0;
      hipGetDevice(&dev);
      hipDeviceGetAttribute(&cus, hipDeviceAttributeMultiprocessorCount, dev);
#if MEGA
      hipFuncSetAttribute((const void*)k_mega, hipFuncAttributeMaxDynamicSharedMemorySize, LDS_BYTES);
      hipOccupancyMaxActiveBlocksPerMultiprocessor(&per_cu, (const void*)k_mega, 256, LDS_BYTES);
#endif
      if (per_cu < 1) per_cu = 1;
      if (per_cu > 2) per_cu = 2;
      grid_blocks = cus * per_cu;
      if (grid_blocks > 512) grid_blocks = 512;
      (void)hipGetLastError();
    }
  }
  if (state < 0) return;
  (void)MiB; (void)in_sizes;
  char* ws = (char*)d_ws;
  P p{};
  const float** f = (const float**)&p;
  for (int i = 0; i < 24; ++i) f[i] = (const float*)d_in[i];
  p.out = (float*)d_out;
  p.wT = (bf16_t*)(ws + o_wT);
  p.rope128 = (float2*)(ws + o_rope128); p.rope64 = (float2*)(ws + o_rope64);
  p.ssmA = (float4*)(ws + o_ssmA); p.ssmB = (float2*)(ws + o_ssmB); p.mod = (float*)(ws + o_mod); p.E = (float2*)(ws + o_E);
  p.XA = (float*)(ws + o_XA);
  p.sel = (unsigned short*)(ws + o_sel);
  p.scr = (unsigned*)(ws + o_scr);
  p.u_ssm = (bf16_t*)(ws + o_ussm); p.q = (bf16_t*)(ws + o_q); p.k = (bf16_t*)(ws + o_k); p.v = (bf16_t*)(ws + o_v);
  p.k8 = (unsigned char*)(ws + o_k); p.v8 = (unsigned char*)(ws + o_v);
  p.qidx = (bf16_t*)(ws + o_qidx); p.kidx = (bf16_t*)(ws + o_kidx); p.widx = (float*)(ws + o_widx);
  p.sg_s = (bf16_t*)(ws + o_sgs); p.sg_a = (bf16_t*)(ws + o_sga);
  p.y_pre = p.qidx;
  p.y_ssm = p.u_ssm;
  p.act = (bf16_t*)(ws + o_sel);
  p.u2 = p.sg_a;
#if MEGA
  void* args[] = {&p};
  hipError_t e = hipLaunchCooperativeKernel((const void*)k_mega, dim3(grid_blocks), dim3(256), args, LDS_BYTES, stream);
  if (e != hipSuccess) fprintf(stderr, "cooperative launch failed: %s (grid %d)\n", hipGetErrorString(e), grid_blocks);
#else
  const int G = 2048;
  launch_phase<PH_PRO>(p, 0, G, stream);
  for (int l = 0; l < 2; ++l) {
    launch_phase<PH_U1>(p, l, G, stream); launch_phase<PH_INPROJ>(p, l, G, stream); launch_phase<PH_SEL>(p, l, G, stream);
    launch_phase<PH_SSMA>(p, l, G, stream); launch_phase<PH_ATTN>(p, l, G, stream); launch_phase<PH_SSMB>(p, l, G, stream);
    launch_phase<PH_CHA>(p, l, G, stream); launch_phase<PH_CHB>(p, l, G, stream);
  }
#endif
}
```

```cpp
#include <hip/hip_runtime.h>
#include <hip/hip_cooperative_groups.h>
#include <cstdio>
#include <cstdint>
namespace cg = cooperative_groups;

#ifndef DIAG_PSEUDO
#define DIAG_PSEUDO 0
#endif
#ifndef DIAG_SCALE
#define DIAG_SCALE 0
#endif
#ifndef MEGA
#define MEGA 1
#endif

typedef unsigned short bf16_t;
typedef short bf16x8 __attribute__((ext_vector_type(8)));
typedef float f32x4 __attribute__((ext_vector_type(4)));
typedef float f32x16 __attribute__((ext_vector_type(16)));
typedef unsigned u32x4 __attribute__((ext_vector_type(4)));
#define DI __device__ __forceinline__

constexpr int SEQ = 8192, NB = 8, DM = 1024, NTOK = NB * SEQ;
constexpr int DINP = 4736;
constexpr int DFF = 2816;
constexpr float ALPHA = 1.41421356237f;
constexpr float IDX_SCALE = 0.04419417382415922f;
constexpr float ATT_SCALE = 0.08838834764831845f;
constexpr int LDS_BYTES = 77824;

constexpr size_t WO_IN = 0, WO_GLU = WO_IN + (size_t)4864 * 1024, WO_PSSM = WO_GLU + 512 * 512, WO_PATTN = WO_PSSM + 1024 * 512,
                 WO_OUT = WO_PATTN + 1024 * 1024, WO_GU = WO_OUT + 1024 * 1024, WO_DOWN = WO_GU + (size_t)5632 * 1024, WO_LAYER = WO_DOWN + (size_t)1024 * DFF;

struct P {
  const float *x, *c, *w_cond, *b_cond, *w_in, *lam_re, *lam_im, *log_dt, *b_re, *b_im, *c_re, *c_im, *d_skip, *w_glu, *b_glu, *p_ssm, *p_attn, *w_out,
      *ln1_g, *ln1_b, *w_gu, *w_down, *ln2_g, *ln2_b;
  float* out;
  bf16_t* wT;
  float2* rope128;
  float2* rope64;
  float4* ssmA;
  float2* ssmB;
  float* mod;
  float2* E;
  float* XA;
  bf16_t *u_ssm, *q, *k, *v, *qidx, *kidx;
  unsigned char *k8, *v8;
  float* widx;
  bf16_t *sg_s, *sg_a;
  unsigned short* sel;
  unsigned* scr;
  bf16_t *y_pre, *y_ssm, *act, *u2;
};

DI int TIDX() { int t = __builtin_amdgcn_workitem_id_x(); asm volatile("" : "+v"(t)); return t; }
DI float bf2f(bf16_t h) { return __uint_as_float(((unsigned)h) << 16); }
DI bf16_t f2bf(float x) { return __builtin_bit_cast(bf16_t, (__bf16)x); }
typedef __bf16 hwbf16x2 __attribute__((ext_vector_type(2)));
typedef float hwf32x2 __attribute__((ext_vector_type(2)));
DI unsigned pack2(float a, float b) { const hwf32x2 f = {a, b}; return __builtin_bit_cast(unsigned, __builtin_convertvector(f, hwbf16x2)); }
DI float sigm(float x) { return __builtin_amdgcn_rcpf(1.f + __expf(-x)); }
DI uint2 pack8_fp8(const float* v) {
  int w0 = 0, w1 = 0;
  w0 = __builtin_amdgcn_cvt_pk_fp8_f32(v[0], v[1], w0, false); w0 = __builtin_amdgcn_cvt_pk_fp8_f32(v[2], v[3], w0, true);
  w1 = __builtin_amdgcn_cvt_pk_fp8_f32(v[4], v[5], w1, false); w1 = __builtin_amdgcn_cvt_pk_fp8_f32(v[6], v[7], w1, true);
  uint2 r; r.x = (unsigned)w0; r.y = (unsigned)w1; return r;
}
typedef float f32x2_t __attribute__((ext_vector_type(2)));
DI void fp8x4_to_bf16x4(unsigned w, unsigned& lo, unsigned& hi) {
  const f32x2_t a = __builtin_amdgcn_cvt_pk_f32_fp8((int)w, false), b = __builtin_amdgcn_cvt_pk_f32_fp8((int)w, true);
  lo = (__float_as_uint(a.x) >> 16) | (__float_as_uint(a.y) & 0xffff0000u);
  hi = (__float_as_uint(b.x) >> 16) | (__float_as_uint(b.y) & 0xffff0000u);
}
DI uint4 pack8(const float* v) { uint4 r; r.x = pack2(v[0], v[1]); r.y = pack2(v[2], v[3]); r.z = pack2(v[4], v[5]); r.w = pack2(v[6], v[7]); return r; }

struct ALoadBf16 {
  const bf16_t* A; int lda;
  DI u32x4 load(int row, int k) const { return *(const u32x4*)(A + (size_t)row * lda + k); }
};
struct ALoadXMod {
  const float* x; const float* sc; const float* sh;
  DI u32x4 load(int row, int k) const {
    const int b = row >> 13;
    const float4* xp = (const float4*)(x + (size_t)row * 1024 + k);
    const float4* sp = (const float4*)(sc + b * 6144 + k);
    const float4* hp = (const float4*)(sh + b * 6144 + k);
    float4 x0 = xp[0], x1 = xp[1], s0 = sp[0], s1 = sp[1], h0 = hp[0], h1 = hp[1];
    u32x4 r;
    r.x = pack2(x0.x * (1.f + s0.x) + h0.x, x0.y * (1.f + s0.y) + h0.y);
    r.y = pack2(x0.z * (1.f + s0.z) + h0.z, x0.w * (1.f + s0.w) + h0.w);
    r.z = pack2(x1.x * (1.f + s1.x) + h1.x, x1.y * (1.f + s1.y) + h1.y);
    r.w = pack2(x1.z * (1.f + s1.z) + h1.z, x1.w * (1.f + s1.w) + h1.w);
    return r;
  }
};

constexpr int LDT = 72;
constexpr int LDC = 132;

template <class AL, class EPI>
DI void gemm_tile(const AL& al, const bf16_t* __restrict__ Bt, int K, int m0, int n0, char* smem, const EPI& epi) {
  bf16_t* As = (bf16_t*)smem;
  bf16_t* Bs = As + 128 * LDT;
  float* Cs = (float*)smem;
  const int tid = TIDX(), lane = tid & 63, wave = tid >> 6, wm = wave >> 1, wn = wave & 1;
  const int lr = lane & 31, lh = lane >> 5;
  f32x16 acc[2][2];
#pragma unroll
  for (int i = 0; i < 2; ++i)
#pragma unroll
    for (int j = 0; j < 2; ++j)
#pragma unroll
      for (int r = 0; r < 16; ++r) acc[i][j][r] = 0.f;
  u32x4 ra[4], rb[4];
  const int nkt = K >> 6;
#pragma unroll
  for (int i = 0; i < 4; ++i) {
    const int c = tid + 256 * i, row = c >> 3, kc = (c & 7) * 8;
    ra[i] = al.load(m0 + row, kc);
    rb[i] = *(const u32x4*)(Bt + (size_t)(n0 + row) * K + kc);
  }
  for (int kt = 0; kt < nkt; ++kt) {
    __syncthreads();
#pragma unroll
    for (int i = 0; i < 4; ++i) {
      const int c = tid + 256 * i, row = c >> 3, kc = (c & 7) * 8;
      *(u32x4*)(As + row * LDT + kc) = ra[i];
      *(u32x4*)(Bs + row * LDT + kc) = rb[i];
    }
    __syncthreads();
    if (kt + 1 < nkt) {
      const int k0 = (kt + 1) << 6;
#pragma unroll
      for (int i = 0; i < 4; ++i) {
        const int c = tid + 256 * i, row = c >> 3, kc = (c & 7) * 8;
        ra[i] = al.load(m0 + row, k0 + kc);
        rb[i] = *(const u32x4*)(Bt + (size_t)(n0 + row) * K + k0 + kc);
      }
    }
#pragma unroll
    for (int ks = 0; ks < 4; ++ks) {
      bf16x8 a[2], b[2];
#pragma unroll
      for (int i = 0; i < 2; ++i) a[i] = *(const bf16x8*)(As + (wm * 64 + i * 32 + lr) * LDT + ks * 16 + lh * 8);
#pragma unroll
      for (int j = 0; j < 2; ++j) b[j] = *(const bf16x8*)(Bs + (wn * 64 + j * 32 + lr) * LDT + ks * 16 + lh * 8);
#pragma unroll
      for (int i = 0; i < 2; ++i)
#pragma unroll
        for (int j = 0; j < 2; ++j) acc[i][j] = __builtin_amdgcn_mfma_f32_32x32x16_bf16(a[i], b[j], acc[i][j], 0, 0, 0);
    }
  }
  __syncthreads();
#pragma unroll
  for (int i = 0; i < 2; ++i)
#pragma unroll
    for (int j = 0; j < 2; ++j)
#pragma unroll
      for (int r = 0; r < 16; ++r) {
        const int row = wm * 64 + i * 32 + (r & 3) + 8 * (r >> 2) + 4 * lh, col = wn * 64 + j * 32 + lr;
        Cs[row * LDC + col] = acc[i][j][r];
      }
  __syncthreads();
  epi(Cs, m0, n0);
}


template <class AL, class EPI>
DI void gemm_wide(const AL& al, const bf16_t* __restrict__ Bt, int K, int m0, int n0, int nhalf, char* smem, const EPI& epi) {
  bf16_t* As = (bf16_t*)smem;
  bf16_t* Bs = As + 128 * LDT;
  float* Cs = (float*)smem;
  const int tid = TIDX(), lane = tid & 63, wave = tid >> 6, wm = wave >> 1, wn = wave & 1;
  const int lr = lane & 31, lh = lane >> 5;
  f32x16 acc[2][4];
#pragma unroll
  for (int i = 0; i < 2; ++i)
#pragma unroll
    for (int j = 0; j < 4; ++j)
#pragma unroll
      for (int r = 0; r < 16; ++r) acc[i][j][r] = 0.f;
  u32x4 ra[4], rb[8];
  const int nkt = K >> 6;
#pragma unroll
  for (int i = 0; i < 8; ++i) {
    const int c = tid + 256 * i, row = c >> 3, kc = (c & 7) * 8;
    if (i < 4) ra[i] = al.load(m0 + row, kc);
    rb[i] = *(const u32x4*)(Bt + (size_t)(n0 + row) * K + kc);
  }
#pragma unroll 1
  for (int kt = 0; kt < nkt; ++kt) {
    __syncthreads();
#pragma unroll
    for (int i = 0; i < 8; ++i) {
      const int c = tid + 256 * i, row = c >> 3, kc = (c & 7) * 8;
      if (i < 4) *(u32x4*)(As + row * LDT + kc) = ra[i];
      *(u32x4*)(Bs + row * LDT + kc) = rb[i];
    }
    __syncthreads();
    if (kt + 1 < nkt) {
      const int k0 = (kt + 1) << 6;
#pragma unroll
      for (int i = 0; i < 8; ++i) {
        const int c = tid + 256 * i, row = c >> 3, kc = (c & 7) * 8;
        if (i < 4) ra[i] = al.load(m0 + row, k0 + kc);
        rb[i] = *(const u32x4*)(Bt + (size_t)(n0 + row) * K + k0 + kc);
      }
    }
    {
      bf16x8 a[2][2], b[2][4];
#pragma unroll
      for (int i = 0; i < 2; ++i) a[0][i] = *(const bf16x8*)(As + (wm * 64 + i * 32 + lr) * LDT + lh * 8);
#pragma unroll
      for (int j = 0; j < 4; ++j) b[0][j] = *(const bf16x8*)(Bs + (wn * 128 + j * 32 + lr) * LDT + lh * 8);
#pragma unroll
      for (int ks = 0; ks < 4; ++ks) {
        if (ks + 1 < 4) {
#pragma unroll
          for (int i = 0; i < 2; ++i) a[(ks + 1) & 1][i] = *(const bf16x8*)(As + (wm * 64 + i * 32 + lr) * LDT + (ks + 1) * 16 + lh * 8);
#pragma unroll
          for (int j = 0; j < 4; ++j) b[(ks + 1) & 1][j] = *(const bf16x8*)(Bs + (wn * 128 + j * 32 + lr) * LDT + (ks + 1) * 16 + lh * 8);
        }
#pragma unroll
        for (int i = 0; i < 2; ++i)
#pragma unroll
          for (int j = 0; j < 4; ++j) acc[i][j] = __builtin_amdgcn_mfma_f32_32x32x16_bf16(a[ks & 1][i], b[ks & 1][j], acc[i][j], 0, 0, 0);
        if (ks + 1 < 4) {
#pragma unroll
          for (int g = 0; g < 6; ++g) {
            __builtin_amdgcn_sched_group_barrier(0x100, 1, 0);
            __builtin_amdgcn_sched_group_barrier(0x008, 1, 0);
          }
          __builtin_amdgcn_sched_group_barrier(0x008, 2, 0);
        } else {
          __builtin_amdgcn_sched_group_barrier(0x008, 8, 0);
        }
      }
    }
  }
#pragma unroll
  for (int half = 0; half < 2; ++half) {
    __syncthreads();
    if (wn == half) {
#pragma unroll
      for (int i = 0; i < 2; ++i)
#pragma unroll
        for (int j = 0; j < 4; ++j)
#pragma unroll
          for (int r = 0; r < 16; ++r) {
            const int row = wm * 64 + i * 32 + (r & 3) + 8 * (r >> 2) + 4 * lh, col = j * 32 + lr;
            Cs[row * LDC + col] = acc[i][j][r];
          }
    }
    __syncthreads();
    if (half < nhalf) epi(Cs, m0, n0 + 128 * half);
  }
}

struct EpiInproj {
  const P& p;
  DI void operator()(const float* Cs, int m0, int n0) const {
    const int nt = n0 >> 7, tid = TIDX();
#pragma unroll 1
    for (int pass = 0; pass < 8; ++pass) {
      const int row = pass * 16 + (tid >> 4), c8 = (tid & 15) * 8;
      const size_t tok = (size_t)(m0 + row);
      const int pos = (int)(tok & 8191);
      const float* cr = Cs + row * LDC;
      float v[8];
      if (nt < 4) {
#pragma unroll
        for (int e = 0; e < 8; ++e) v[e] = cr[c8 + e];
        *(uint4*)(p.u_ssm + tok * 512 + nt * 128 + c8) = pack8(v);
      } else if (nt < 14) {
        const float2* rt = p.rope128 + pos * 64;
        if (c8 < 64) {
#pragma unroll
          for (int e = 0; e < 8; ++e) { const int c = c8 + e; const float2 cs = rt[c]; v[e] = cr[c] * cs.x - cr[c + 64] * cs.y; }
        } else {
#pragma unroll
          for (int e = 0; e < 8; ++e) { const int c = c8 + e, cc = c - 64; const float2 cs = rt[cc]; v[e] = cr[c] * cs.x + cr[cc] * cs.y; }
        }
        if (nt < 12) *(uint4*)(p.q + tok * 1024 + (nt - 4) * 128 + c8) = pack8(v);
        else *(uint2*)(p.k8 + tok * 256 + (nt - 12) * 128 + c8) = pack8_fp8(v);
      } else if (nt < 16) {
#pragma unroll
        for (int e = 0; e < 8; ++e) v[e] = cr[c8 + e];
        *(uint2*)(p.v8 + tok * 256 + (nt - 14) * 128 + c8) = pack8_fp8(v);
      } else if (nt < 20 || (nt == 20 && c8 < 64)) {
        const float2* rt = p.rope64 + pos * 32;
        const int cl = c8 & 63;
        if (cl < 32) {
#pragma unroll
          for (int e = 0; e < 8; ++e) { const int c = c8 + e; const float2 cs = rt[cl + e]; v[e] = cr[c] * cs.x - cr[c + 32] * cs.y; }
        } else {
#pragma unroll
          for (int e = 0; e < 8; ++e) { const int c = c8 + e; const float2 cs = rt[cl + e - 32]; v[e] = cr[c] * cs.x + cr[c - 32] * cs.y; }
        }
        bf16_t* dst = (nt < 20) ? (p.qidx + tok * 512 + (nt - 16) * 128 + c8) : (p.kidx + tok * 64 + c8);
        *(uint4*)dst = pack8(v);
      } else if (nt == 20) {
        if (c8 == 64) {
          float4 w0, w1;
          w0.x = cr[64] * IDX_SCALE; w0.y = cr[65] * IDX_SCALE; w0.z = cr[66] * IDX_SCALE; w0.w = cr[67] * IDX_SCALE;
          w1.x = cr[68] * IDX_SCALE; w1.y = cr[69] * IDX_SCALE; w1.z = cr[70] * IDX_SCALE; w1.w = cr[71] * IDX_SCALE;
          *(float4*)(p.widx + tok * 8) = w0; *(float4*)(p.widx + tok * 8 + 4) = w1;
        }
      } else {
#pragma unroll
        for (int e = 0; e < 8; ++e) v[e] = sigm(cr[c8 + e]);
        bf16_t* dst = (nt < 29) ? (p.sg_s + tok * 1024 + (nt - 21) * 128 + c8) : (p.sg_a + tok * 1024 + (nt - 29) * 128 + c8);
        *(uint4*)dst = pack8(v);
      }
    }
  }
};

struct EpiGlu {
  const P& p; const float* bglu;
  DI void operator()(const float* Cs, int m0, int n0) const {
    const int tid = TIDX(), c8 = (tid & 15) * 8, r0 = tid >> 4;
    u32x4 yr[8];
#pragma unroll
    for (int pass = 0; pass < 8; ++pass) yr[pass] = *(const u32x4*)(p.y_pre + (size_t)(m0 + pass * 16 + r0) * 512 + n0 + c8);
    float bg[8];
#pragma unroll
    for (int e = 0; e < 8; ++e) bg[e] = bglu[n0 + c8 + e];
#pragma unroll
    for (int pass = 0; pass < 8; ++pass) {
      const int row = pass * 16 + r0;
      const float* cr = Cs + row * LDC + c8;
      float v[8];
#pragma unroll
      for (int e = 0; e < 8; ++e) {
        const unsigned w = yr[pass][e >> 1];
        const float y = __uint_as_float((e & 1) ? (w & 0xffff0000u) : (w << 16));
        v[e] = y * sigm(cr[e] + bg[e]);
      }
      *(uint4*)(p.y_ssm + (size_t)(m0 + row) * 512 + n0 + c8) = pack8(v);
    }
  }
};

struct EpiMerge1 {
  const P& p;
  DI void operator()(const float* Cs, int m0, int n0) const {
    const int tid = TIDX(), c8 = (tid & 15) * 8, r0 = tid >> 4;
    u32x4 gr[8];
#pragma unroll
    for (int pass = 0; pass < 8; ++pass) gr[pass] = *(const u32x4*)(p.sg_s + (size_t)(m0 + pass * 16 + r0) * 1024 + n0 + c8);
#pragma unroll
    for (int pass = 0; pass < 8; ++pass) {
      const int row = pass * 16 + r0;
      const float* cr = Cs + row * LDC + c8;
      float v[8];
#pragma unroll
      for (int e = 0; e < 8; ++e) {
        const unsigned w = gr[pass][e >> 1];
        const float g = __uint_as_float((e & 1) ? (w & 0xffff0000u) : (w << 16));
        v[e] = g * cr[e];
      }
      *(uint4*)(p.sg_s + (size_t)(m0 + row) * 1024 + n0 + c8) = pack8(v);
    }
  }
};
struct EpiMerge2 {
  const P& p;
  DI void operator()(const float* Cs, int m0, int n0) const {
    const int tid = TIDX(), c8 = (tid & 15) * 8, r0 = tid >> 4;
    u32x4 gr[8], pr[8];
#pragma unroll
    for (int pass = 0; pass < 8; ++pass) {
      gr[pass] = *(const u32x4*)(p.sg_a + (size_t)(m0 + pass * 16 + r0) * 1024 + n0 + c8);
      pr[pass] = *(const u32x4*)(p.sg_s + (size_t)(m0 + pass * 16 + r0) * 1024 + n0 + c8);
    }
#pragma unroll
    for (int pass = 0; pass < 8; ++pass) {
      const int row = pass * 16 + r0;
      const float* cr = Cs + row * LDC + c8;
      float v[8];
#pragma unroll
      for (int e = 0; e < 8; ++e) {
        const unsigned wg = gr[pass][e >> 1], wp = pr[pass][e >> 1];
        const float g = __uint_as_float((e & 1) ? (wg & 0xffff0000u) : (wg << 16));
        const float pa = __uint_as_float((e & 1) ? (wp & 0xffff0000u) : (wp << 16));
        v[e] = pa + g * cr[e];
      }
      *(uint4*)(p.sg_s + (size_t)(m0 + row) * 1024 + n0 + c8) = pack8(v);
    }
  }
};
struct EpiResid {
  const float* xin; const float* gt; float* dst;
  DI void operator()(const float* Cs, int m0, int n0) const {
    const int tid = TIDX(), c8 = (tid & 15) * 8, r0 = tid >> 4;
    const int b = m0 >> 13;
    f32x4 xa[8], xb[8];
#pragma unroll
    for (int pass = 0; pass < 8; ++pass) {
      const f32x4* xs = (const f32x4*)(xin + (size_t)(m0 + pass * 16 + r0) * 1024 + n0 + c8);
      xa[pass] = xs[0]; xb[pass] = xs[1];
    }
    const f32x4* gs = (const f32x4*)(gt + b * 6144 + n0 + c8);
    const f32x4 g0 = gs[0], g1 = gs[1];
#pragma unroll
    for (int pass = 0; pass < 8; ++pass) {
      const int row = pass * 16 + r0;
      const float* cr = Cs + row * LDC + c8;
      f32x4 o0, o1;
#pragma unroll
      for (int e = 0; e < 4; ++e) { o0[e] = ALPHA * xa[pass][e] + (1.f + g0[e]) * cr[e]; o1[e] = ALPHA * xb[pass][e] + (1.f + g1[e]) * cr[4 + e]; }
      f32x4* d = (f32x4*)(dst + (size_t)(m0 + row) * 1024 + n0 + c8);
      d[0] = o0; d[1] = o1;
    }
  }
};
struct EpiGateUp {
  const P& p;
  DI void operator()(const float* Cs, int m0, int n0) const {
    const int tid = TIDX(), j = n0 >> 7;
#pragma unroll 1
    for (int pass = 0; pass < 4; ++pass) {
      const int row = pass * 32 + (tid >> 3), c8 = (tid & 7) * 8;
      const size_t tok = (size_t)(m0 + row);
      const float* cr = Cs + row * LDC + c8;
      float v[8];
#pragma unroll
      for (int e = 0; e < 8; ++e) { const float a = cr[e], bb = cr[64 + e]; v[e] = a * sigm(a) * bb; }
      *(uint4*)(p.act + tok * DFF + j * 64 + c8) = pack8(v);
    }
  }
};

DI int colmap(int mode, int n) {
  if (mode == 0) return n;
  if (mode == 1) return n < 2632 ? n : (n < 2688 ? -1 : (n < 4736 ? n - 56 : -1));
  const int j = n >> 7, r = n & 127;
  return r < 64 ? (64 * j + r) : (2816 + 64 * j + (r - 64));
}
DI void transpose_item(const float* __restrict__ src, int K, int Ns, bf16_t* __restrict__ dst, int mode, int item, char* smem) {
  float* T = (float*)smem;
  const int nkt = K >> 6, kt = item % nkt, nt = item / nkt, k0 = kt * 64, n0 = nt * 64, tid = TIDX();
  __syncthreads();
  {
    const int n = n0 + (tid & 63), sc = colmap(mode, n);
#pragma unroll 4
    for (int rr = 0; rr < 16; ++rr) {
      const int r = rr * 4 + (tid >> 6);
      T[r * 65 + (tid & 63)] = sc >= 0 ? src[(size_t)(k0 + r) * Ns + sc] : 0.f;
    }
  }
  __syncthreads();
#pragma unroll 4
  for (int rr = 0; rr < 16; ++rr) {
    const int nn = rr * 4 + (tid >> 6);
    dst[(size_t)(n0 + nn) * K + k0 + (tid & 63)] = f2bf(T[(tid & 63) * 65 + nn]);
  }
}

constexpr int TR_IN = 76 * 16, TR_GLU = 64, TR_PSSM = 16 * 8, TR_PATTN = 256, TR_OUT = 256, TR_GU = 88 * 16, TR_DOWN = 16 * 44;
constexpr int TR_LAYER = TR_IN + TR_GLU + TR_PSSM + TR_PATTN + TR_OUT + TR_GU + TR_DOWN;
constexpr int N_TR = 2 * TR_LAYER, N_COND = 2 * 192, N_ROPE = 8192 / 8, N_SSMT = (2 * 32 * 64) / 256;
constexpr int N_PRO = N_TR + N_COND + N_ROPE + N_SSMT;

DI void prologue_item(const P& p, int item, char* smem) {
  const int tid = TIDX();
  if (item < N_TR) {
    const int l = item / TR_LAYER; int it = item % TR_LAYER;
    bf16_t* wl = p.wT + (size_t)l * WO_LAYER;
    if (it < TR_IN) { transpose_item(p.w_in + (size_t)l * 1024 * 4680, 1024, 4680, wl + WO_IN, 1, it, smem); return; } it -= TR_IN;
    if (it < TR_GLU) { transpose_item(p.w_glu + (size_t)l * 512 * 512, 512, 512, wl + WO_GLU, 0, it, smem); return; } it -= TR_GLU;
    if (it < TR_PSSM) { transpose_item(p.p_ssm + (size_t)l * 512 * 1024, 512, 1024, wl + WO_PSSM, 0, it, smem); return; } it -= TR_PSSM;
    if (it < TR_PATTN) { transpose_item(p.p_attn + (size_t)l * 1024 * 1024, 1024, 1024, wl + WO_PATTN, 0, it, smem); return; } it -= TR_PATTN;
    if (it < TR_OUT) { transpose_item(p.w_out + (size_t)l * 1024 * 1024, 1024, 1024, wl + WO_OUT, 0, it, smem); return; } it -= TR_OUT;
    if (it < TR_GU) { transpose_item(p.w_gu + (size_t)l * 1024 * 5632, 1024, 5632, wl + WO_GU, 2, it, smem); return; } it -= TR_GU;
    transpose_item(p.w_down + (size_t)l * DFF * 1024, DFF, 1024, wl + WO_DOWN, 0, it, smem); return;
  }
  item -= N_TR;
  if (item < N_COND) {
    const int l = item / 192, n0 = (item % 192) * 32;
    float* sc = (float*)smem;
    float* red = sc + 8192;
    __syncthreads();
    for (int i = tid; i < 8192; i += 256) { const float cv = p.c[i]; sc[i] = cv * sigm(cv); }
    __syncthreads();
    const int nn = tid & 31, kc = tid >> 5;
    float acc[8];
#pragma unroll
    for (int b = 0; b < 8; ++b) acc[b] = 0.f;
    const float* wp = p.w_cond + ((size_t)l * 1024 + kc * 128) * 6144 + n0 + nn;
    for (int k = 0; k < 128; ++k) {
      const float w = wp[(size_t)k * 6144];
#pragma unroll
      for (int b = 0; b < 8; ++b) acc[b] += sc[b * 1024 + kc * 128 + k] * w;
    }
#pragma unroll
    for (int b = 0; b < 8; ++b) red[(kc * 8 + b) * 32 + nn] = acc[b];
    __syncthreads();
    {
      const int b = tid >> 5;
      float s = 0.f;
#pragma unroll
      for (int q = 0; q < 8; ++q) s += red[(q * 8 + b) * 32 + nn];
      p.mod[((size_t)l * 8 + b) * 6144 + n0 + nn] = s + p.b_cond[l * 6144 + n0 + nn];
    }
    return;
  }
  item -= N_COND;
  if (item < N_ROPE) {
#pragma unroll 1
    for (int k = 0; k < 3; ++k) {
      const int e = tid + 256 * k;
      const int pos = item * 8 + e / 96, j = e % 96;
      if (j < 64) {
        const float inv = (float)pow(10000.0, -(double)j / 64.0);
        const float ang = (float)pos * inv;
        p.rope128[pos * 64 + j] = make_float2((float)cos((double)ang), (float)sin((double)ang));
      } else {
        const int i = j - 64;
        const float inv = (float)pow(10000.0, -(double)i / 32.0);
        const float ang = (float)pos * inv;
        p.rope64[pos * 32 + i] = make_float2((float)cos((double)ang), (float)sin((double)ang));
      }
    }
    return;
  }
  item -= N_ROPE;
  {
    const int idx = item * 256 + tid;
    const int lg = idx >> 6;
    const double dt = exp((double)p.log_dt[lg]);
    const double lr = p.lam_re[idx], li = p.lam_im[idx];
    const double mag = exp(lr * dt), ar = mag * cos(li * dt), ai = mag * sin(li * dt);
    const double mag128 = exp(lr * dt * 128.0), ar128 = mag128 * cos(li * dt * 128.0), ai128 = mag128 * sin(li * dt * 128.0);
    const double den = lr * lr + li * li, nr = ar - 1.0;
    const double fr = (nr * lr + ai * li) / den, fi = (ai * lr - nr * li) / den;
    p.ssmA[idx] = make_float4((float)ar, (float)ai, (float)ar128, (float)ai128);
    for (int i = 0; i < 16; ++i) {
      const double br = p.b_re[(size_t)idx * 16 + i], bi = p.b_im[(size_t)idx * 16 + i];
      p.ssmB[(size_t)idx * 16 + i] = make_float2((float)(fr * br - fi * bi), (float)(fr * bi + fi * br));
    }
  }
}

template <bool FULL>
DI void ssm_item(const P& p, int l, int item, char* smem) {
  const int tid = TIDX(), lane = tid & 63, wave = tid >> 6;
  const int b = item >> 9, c = (item >> 3) & 63, g = (item & 7) * 4 + wave;
  float* H = (float*)smem + wave * (16 * 132 + 256);
  float* us = H + 16 * 132;
  const int lg = l * 32 + g;
  const float4 a4 = p.ssmA[lg * 64 + lane];
  const float ar = a4.x, ai = a4.y;
  float bbr[16], bbi[16];
  {
    const float4* bp = (const float4*)(p.ssmB + ((size_t)lg * 64 + lane) * 16);
#pragma unroll
    for (int i = 0; i < 8; ++i) { const float4 t = bp[i]; bbr[2 * i] = t.x; bbi[2 * i] = t.y; bbr[2 * i + 1] = t.z; bbi[2 * i + 1] = t.w; }
  }
  float hr = 0.f, hi = 0.f;
  const int ch = lane & 15, quad = lane >> 4;
  float creg[32];
  float dsk = 0.f;
  if (FULL) {
    const float2* Ep = p.E + ((size_t)(b * 32 + g) * 64) * 64 + lane;
    for (int cc = 0; cc < c; ++cc) {
      const float2 e = Ep[cc * 64];
      const float nhr = a4.z * hr - a4.w * hi + e.x, nhi = a4.z * hi + a4.w * hr + e.y;
      hr = nhr; hi = nhi;
    }
    const float* cp = (quad < 2 ? p.c_re : p.c_im) + ((size_t)lg * 16 + ch) * 64 + (quad & 1) * 32;
    const float sgn = quad < 2 ? 1.f : -1.f;
#pragma unroll
    for (int i = 0; i < 8; ++i) { const float4 t = ((const float4*)cp)[i]; creg[4 * i] = sgn * t.x; creg[4 * i + 1] = sgn * t.y; creg[4 * i + 2] = sgn * t.z; creg[4 * i + 3] = sgn * t.w; }
    dsk = p.d_skip[l * 512 + g * 16 + ch];
  }
  const size_t tok0 = (size_t)b * SEQ + c * 128;
  const int tt = lane >> 2, part = lane & 3;
  uint2 raw = *(const uint2*)(p.u_ssm + (tok0 + tt) * 512 + g * 16 + part * 4);
#pragma unroll 1
  for (int s = 0; s < 8; ++s) {
    float4 uf;
    uf.x = __uint_as_float(raw.x << 16); uf.y = __uint_as_float(raw.x & 0xffff0000u);
    uf.z = __uint_as_float(raw.y << 16); uf.w = __uint_as_float(raw.y & 0xffff0000u);
    __builtin_amdgcn_wave_barrier();
    *(float4*)(us + tt * 16 + part * 4) = uf;
    __builtin_amdgcn_wave_barrier();
    if (s + 1 < 8) raw = *(const uint2*)(p.u_ssm + (tok0 + (s + 1) * 16 + tt) * 512 + g * 16 + part * 4);
#pragma unroll 4
    for (int t = 0; t < 16; ++t) {
      const float4* up = (const float4*)(us + t * 16);
      const float4 u0 = up[0], u1 = up[1], u2 = up[2], u3 = up[3];
      const float uu[16] = {u0.x, u0.y, u0.z, u0.w, u1.x, u1.y, u1.z, u1.w, u2.x, u2.y, u2.z, u2.w, u3.x, u3.y, u3.z, u3.w};
      float br = 0.f, bi = 0.f;
#pragma unroll
      for (int i = 0; i < 16; ++i) { br = fmaf(bbr[i], uu[i], br); bi = fmaf(bbi[i], uu[i], bi); }
      const float nhr = ar * hr - ai * hi + br, nhi = ar * hi + ai * hr + bi;
      hr = nhr; hi = nhi;
      if (FULL) { H[t * 132 + lane] = hr; H[t * 132 + 64 + lane] = hi; }
    }
    if (FULL) {
      __builtin_amdgcn_wave_barrier();
      f32x4 acc = {0.f, 0.f, 0.f, 0.f};
      const float* hp = H + ch * 132 + quad * 32;
#pragma unroll
      for (int i = 0; i < 8; ++i) {
        const float4 hv = *(const float4*)(hp + 4 * i);
        acc = __builtin_amdgcn_mfma_f32_16x16x4f32(hv.x, creg[4 * i], acc, 0, 0, 0);
        acc = __builtin_amdgcn_mfma_f32_16x16x4f32(hv.y, creg[4 * i + 1], acc, 0, 0, 0);
        acc = __builtin_amdgcn_mfma_f32_16x16x4f32(hv.z, creg[4 * i + 2], acc, 0, 0, 0);
        acc = __builtin_amdgcn_mfma_f32_16x16x4f32(hv.w, creg[4 * i + 3], acc, 0, 0, 0);
      }
#pragma unroll
      for (int r = 0; r < 4; ++r) {
        const int tl = quad * 4 + r;
        float y = acc[r] + dsk * us[tl * 16 + ch];
        const float y3 = y * y * y;
        y = y * sigm(1.5957691216057308f * (y + 0.044715f * y3));
        p.y_pre[(tok0 + s * 16 + tl) * 512 + g * 16 + ch] = f2bf(y);
      }
    }
  }
  if (!FULL) p.E[((size_t)(b * 32 + g) * 64 + c) * 64 + lane] = make_float2(hr, hi);
}

DI unsigned mono(float f) { const unsigned u = __float_as_uint(f); return (u & 0x80000000u) ? ~u : (u | 0x80000000u); }

struct SelPre { bf16x8 a[4]; float4 w[4]; };
DI void select_prefetch(const P& p, int b, int quad4, SelPre& pre) {
  const int t0 = quad4 * 4;
  if (t0 < 256) return;
  const int lane = TIDX() & 63, r = lane & 31, h = lane >> 5;
  const size_t tok0 = (size_t)b * SEQ + t0;
  const bf16_t* qp = p.qidx + (tok0 + (r >> 3)) * 512 + (r & 7) * 64 + h * 8;
#pragma unroll
  for (int s = 0; s < 4; ++s) pre.a[s] = *(const bf16x8*)(qp + s * 16);
#pragma unroll
  for (int q = 0; q < 4; ++q) pre.w[q] = *(const float4*)(p.widx + (tok0 + q) * 8 + h * 4);
}
DI void select_item(const P& p, int b, int quad4, int bid, char* smem, const SelPre& pre) {
  const int t0 = quad4 * 4;
  if (t0 < 256) return;
  const int tid = TIDX(), lane = tid & 63, wave = tid >> 6;
  unsigned* hist = (unsigned*)smem + wave * 256;
  unsigned* candi = (unsigned*)smem + 1024 + wave * 512;
  unsigned* candk = candi + 256;
  unsigned short* sc16 = (unsigned short*)((unsigned*)smem + 3072);
  unsigned* scr = p.scr + (size_t)bid * 4 * 8192;
  const size_t tok0 = (size_t)b * SEQ + t0;
  __syncthreads();
  {
    const int r = lane & 31, h = lane >> 5;
    bf16x8 a[4];
    float4 w[4];
#pragma unroll
    for (int s = 0; s < 4; ++s) { a[s] = pre.a[s]; w[s] = pre.w[s]; }
    const int ntile = (t0 + 4 + 31) >> 5;
    const bf16_t* kbase = p.kidx + ((size_t)b * SEQ) * 64 + h * 8;
    const int nit = (ntile - wave + 3) >> 2;
#pragma unroll 1
    for (int i0 = 0; i0 < nit; i0 += 4) {
      bf16x8 bf[4][4];
#pragma unroll
      for (int u = 0; u < 4; ++u) {
        int kt = wave + 4 * (i0 + u); kt = kt < ntile ? kt : ntile - 1;
        const bf16_t* kp = kbase + (size_t)(kt * 32 + r) * 64;
#pragma unroll
        for (int s = 0; s < 4; ++s) bf[u][s] = *(const bf16x8*)(kp + s * 16);
      }
#pragma unroll
      for (int u = 0; u < 4; ++u) {
        const int key = (wave + 4 * (i0 + u)) * 32 + r;
        f32x16 acc;
#pragma unroll
        for (int i = 0; i < 16; ++i) acc[i] = 0.f;
#pragma unroll
        for (int s = 0; s < 4; ++s) acc = __builtin_amdgcn_mfma_f32_32x32x16_bf16(a[s], bf[u][s], acc, 0, 0, 0);
        float tot[4];
#pragma unroll
        for (int q = 0; q < 4; ++q) {
          float sq = 0.f;
          sq = fmaf(fmaxf(acc[4 * q + 0], 0.f), w[q].x, sq); sq = fmaf(fmaxf(acc[4 * q + 1], 0.f), w[q].y, sq);
          sq = fmaf(fmaxf(acc[4 * q + 2], 0.f), w[q].z, sq); sq = fmaf(fmaxf(acc[4 * q + 3], 0.f), w[q].w, sq);
          tot[q] = sq + __shfl_xor(sq, 32);
        }
        if (i0 + u < nit) {
          const unsigned m0 = mono(h == 0 ? tot[0] : tot[2]), m1 = mono(h == 0 ? tot[1] : tot[3]);
          const int q0 = h * 2;
          sc16[q0 * 8192 + key] = (unsigned short)(m0 >> 16); sc16[(q0 + 1) * 8192 + key] = (unsigned short)(m1 >> 16);
          __builtin_nontemporal_store(m0, scr + q0 * 8192 + key); __builtin_nontemporal_store(m1, scr + (q0 + 1) * 8192 + key);
        }
      }
    }
  }
  __syncthreads();
  {
    const int qi = wave, n = t0 + qi + 1;
    const unsigned short* s = sc16 + qi * 8192;
    const unsigned* s32 = (const unsigned*)s;
    unsigned prefix = 0, pmask = 0, need = 256, eq_total = 0;
#pragma unroll 1
    for (int pass = 0; pass < 2; ++pass) {
      const int shift = 8 - 8 * pass;
#pragma unroll
      for (int k = 0; k < 4; ++k) hist[lane + 64 * k] = 0;
      __builtin_amdgcn_wave_barrier();
      for (int e2 = lane; 2 * e2 < n; e2 += 64) {
        const unsigned wv = s32[e2];
        const unsigned k0 = wv & 0xffffu, k1 = wv >> 16;
        if ((k0 & pmask) == prefix) atomicAdd(&hist[(k0 >> shift) & 255], 1u);
        if (2 * e2 + 1 < n && (k1 & pmask) == prefix) atomicAdd(&hist[(k1 >> shift) & 255], 1u);
      }
      __builtin_amdgcn_wave_barrier();
      const uint4 h4 = *(const uint4*)(hist + 4 * lane);
      const unsigned sum = h4.x + h4.y + h4.z + h4.w;
      unsigned incl = sum;
#pragma unroll
      for (int off = 1; off < 64; off <<= 1) { const unsigned v = __shfl_down(incl, off); if (lane + off < 64) incl += v; }
      unsigned above = incl - sum;
      const bool found = above < need && need <= incl;
      unsigned dig = 0, cnt = 0;
      if (found) {
        if (above + h4.w >= need) { dig = 3; cnt = h4.w; }
        else { above += h4.w;
          if (above + h4.z >= need) { dig = 2; cnt = h4.z; }
          else { above += h4.z;
            if (above + h4.y >= need) { dig = 1; cnt = h4.y; }
            else { above += h4.y; dig = 0; cnt = h4.x; } } }
        dig += 4 * lane;
      }
      const unsigned long long fb = __ballot(found);
      const int fl = fb ? (__ffsll((long long)fb) - 1) : 0;
      const unsigned dsel = __shfl(dig, fl), nneed = __shfl(need - above, fl), ncnt = __shfl(cnt, fl);
      prefix |= dsel << shift; pmask |= 0xffu << shift; need = nneed; eq_total = ncnt;
      __builtin_amdgcn_wave_barrier();
    }
    const unsigned thr = prefix, ngt = 256 - need;
    unsigned short* dst = p.sel + (tok0 + qi) * 256;
    const unsigned long long lm = (1ull << lane) - 1ull;
    unsigned og = 0, oe = 0;
    for (int base = 0; base < n; base += 64) {
      const int e = base + lane;
      const unsigned u = e < n ? (unsigned)s[e] : 0u;
      const bool isg = e < n && u > thr, ise = e < n && u == thr;
      const unsigned long long bg = __ballot(isg), be = __ballot(ise);
      if (isg) { const unsigned pos = og + __popcll(bg & lm); if (pos < 256u) dst[pos] = (unsigned short)e; }
      if (ise) { const unsigned rr = oe + __popcll(be & lm); if (rr < 256u) candi[rr] = (unsigned)e; }
      og += __popcll(bg); oe += __popcll(be);
    }
    __builtin_amdgcn_wave_barrier();
    const unsigned c = eq_total < 256u ? eq_total : 256u;
    if (eq_total == need) {
      for (unsigned i = lane; i < c; i += 64) if (ngt + i < 256u) dst[ngt + i] = (unsigned short)candi[i];
    } else {
      for (unsigned i = lane; i < c; i += 64) candk[i] = __hip_atomic_load(scr + qi * 8192 + candi[i], __ATOMIC_RELAXED, __HIP_MEMORY_SCOPE_AGENT);
      __builtin_amdgcn_wave_barrier();
      for (unsigned i = lane; i < c; i += 64) {
        const unsigned ki = candk[i];
        unsigned rank = 0;
        for (unsigned j2 = 0; j2 < c; ++j2) { const unsigned kj = candk[j2]; rank += (kj > ki || (kj == ki && j2 < i)) ? 1u : 0u; }
        if (rank < need && ngt + rank < 256u) dst[ngt + rank] = (unsigned short)candi[i];
      }
    }
  }
  __syncthreads();
}

struct AttnPre { uint2 sv; u32x4 tq[4]; };
DI void attn_prefetch(const P& p, int b, int kvh, int quad4, AttnPre& pre) {
  const int tid = TIDX(), lane = tid & 63, wave = tid >> 6;
  const int t = quad4 * 4 + wave;
  const size_t tok = (size_t)b * SEQ + t;
  const int r = lane & 15, quad = lane >> 4;
  pre.sv = make_uint2(0u, 0u);
  if (t >= 256) pre.sv = *(const uint2*)(p.sel + tok * 256 + lane * 4);
  const bf16_t* qp = p.q + tok * 1024 + (kvh * 4 + (r & 3)) * 128 + quad * 16;
#pragma unroll
  for (int s = 0; s < 4; ++s) pre.tq[s] = *(const u32x4*)(qp + (s >> 1) * 64 + (s & 1) * 8);
}
DI void attn_item(const P& p, int b, int kvh, int quad4, char* smem, const AttnPre& pre) {
  const int tid = TIDX(), lane = tid & 63, wave = tid >> 6;
  const int t = quad4 * 4 + wave;
  const size_t tok = (size_t)b * SEQ + t;
  float* L = (float*)smem + wave * (1024 + 256);
  int* idx = (int*)(L + 1024);
  const int cnt = t < 256 ? t + 1 : 256;
  __builtin_amdgcn_wave_barrier();
  if (t < 256) {
#pragma unroll
    for (int j = 0; j < 4; ++j) { const int n = lane + 64 * j; idx[n] = n < cnt ? n : 0; }
  } else {
    const uint2 sv = pre.sv;
    idx[lane * 4 + 0] = sv.x & 0xffff; idx[lane * 4 + 1] = sv.x >> 16; idx[lane * 4 + 2] = sv.y & 0xffff; idx[lane * 4 + 3] = sv.y >> 16;
  }
  const int r = lane & 15, quad = lane >> 4;
  long qa8[4];
  {
    const bf16_t* qp = p.q + tok * 1024 + (kvh * 4 + (r & 3)) * 128 + quad * 16;
#pragma unroll
    for (int s = 0; s < 4; ++s) {
      const u32x4 tq = pre.tq[s];
      float f[8];
#pragma unroll
      for (int e = 0; e < 4; ++e) { f[2 * e] = __uint_as_float(tq[e] << 16); f[2 * e + 1] = __uint_as_float(tq[e] & 0xffff0000u); }
      const uint2 pk = pack8_fp8(f);
      long v = (long)(((unsigned long long)pk.y << 32) | (unsigned long long)pk.x);
      if (r >= 4) v = 0;
      qa8[s] = v;
    }
  }
  __builtin_amdgcn_wave_barrier();
  const unsigned char* kb = p.k8 + ((size_t)b * SEQ) * 256 + kvh * 128 + quad * 16;
  int myidx[16];
#pragma unroll
  for (int kt = 0; kt < 16; ++kt) myidx[kt] = idx[kt * 16 + r];
#pragma unroll
  for (int kt0 = 0; kt0 < 16; kt0 += 8) {
    u32x4 kraw[8][2];
#pragma unroll
    for (int u = 0; u < 8; ++u) {
      const unsigned char* kp = kb + (size_t)myidx[kt0 + u] * 256;
      kraw[u][0] = *(const u32x4*)kp; kraw[u][1] = *(const u32x4*)(kp + 64);
    }
#pragma unroll
    for (int u = 0; u < 8; ++u) {
      const int n = (kt0 + u) * 16 + r;
      f32x4 acc = {0.f, 0.f, 0.f, 0.f};
#pragma unroll
      for (int S = 0; S < 2; ++S) {
        const long k0 = (long)(((unsigned long long)kraw[u][S][1] << 32) | (unsigned long long)kraw[u][S][0]);
        const long k1 = (long)(((unsigned long long)kraw[u][S][3] << 32) | (unsigned long long)kraw[u][S][2]);
        acc = __builtin_amdgcn_mfma_f32_16x16x32_fp8_fp8(qa8[2 * S], k0, acc, 0, 0, 0);
        acc = __builtin_amdgcn_mfma_f32_16x16x32_fp8_fp8(qa8[2 * S + 1], k1, acc, 0, 0, 0);
      }
      if (quad == 0) {
        const bool ok = n < cnt;
#pragma unroll
        for (int h = 0; h < 4; ++h) L[h * 256 + n] = ok ? acc[h] * ATT_SCALE : -INFINITY;
      }
    }
  }
  __builtin_amdgcn_wave_barrier();
  float pr[4][4];
#pragma unroll
  for (int h = 0; h < 4; ++h) {
    float m = -INFINITY;
#pragma unroll
    for (int j = 0; j < 4; ++j) { pr[h][j] = L[h * 256 + lane + 64 * j]; m = fmaxf(m, pr[h][j]); }
#pragma unroll
    for (int off = 32; off >= 1; off >>= 1) m = fmaxf(m, __shfl_xor(m, off));
    float sum = 0.f;
#pragma unroll
    for (int j = 0; j < 4; ++j) { pr[h][j] = __expf(pr[h][j] - m); sum += pr[h][j]; }
#pragma unroll
    for (int off = 32; off >= 1; off >>= 1) sum += __shfl_xor(sum, off);
    const float inv = 1.f / sum;
#pragma unroll
    for (int j = 0; j < 4; ++j) pr[h][j] *= inv;
  }
  __builtin_amdgcn_wave_barrier();
#pragma unroll
  for (int j = 0; j < 4; ++j) *(float4*)(L + (lane + 64 * j) * 4) = make_float4(pr[0][j], pr[1][j], pr[2][j], pr[3][j]);
  __builtin_amdgcn_wave_barrier();
  float o[4][8];
#pragma unroll
  for (int h = 0; h < 4; ++h)
#pragma unroll
    for (int e = 0; e < 8; ++e) o[h][e] = 0.f;
  const unsigned char* vb = p.v8 + ((size_t)b * SEQ) * 256 + kvh * 128 + r * 8;
#pragma unroll 1
  for (int n0 = 0; n0 < 256; n0 += 64) {
    uint2 vv[16];
#pragma unroll
    for (int u = 0; u < 16; ++u) vv[u] = *(const uint2*)(vb + (size_t)idx[n0 + 4 * u + quad] * 256);
#pragma unroll
    for (int u = 0; u < 16; ++u) {
      const float4 p4 = *(const float4*)(L + (n0 + 4 * u + quad) * 4);
      const f32x2_t c0 = __builtin_amdgcn_cvt_pk_f32_fp8((int)vv[u].x, false), c1 = __builtin_amdgcn_cvt_pk_f32_fp8((int)vv[u].x, true);
      const f32x2_t c2 = __builtin_amdgcn_cvt_pk_f32_fp8((int)vv[u].y, false), c3 = __builtin_amdgcn_cvt_pk_f32_fp8((int)vv[u].y, true);
      const float vf[8] = {c0.x, c0.y, c1.x, c1.y, c2.x, c2.y, c3.x, c3.y};
#pragma unroll
      for (int e = 0; e < 8; ++e) {
        o[0][e] = fmaf(p4.x, vf[e], o[0][e]); o[1][e] = fmaf(p4.y, vf[e], o[1][e]);
        o[2][e] = fmaf(p4.z, vf[e], o[2][e]); o[3][e] = fmaf(p4.w, vf[e], o[3][e]);
      }
    }
  }
#pragma unroll
  for (int h = 0; h < 4; ++h)
#pragma unroll
    for (int e = 0; e < 8; ++e) { float v = o[h][e]; v += __shfl_xor(v, 16); v += __shfl_xor(v, 32); o[h][e] = v; }
  if (quad == 0) {
#pragma unroll
    for (int h = 0; h < 4; ++h) *(uint4*)(p.q + tok * 1024 + (kvh * 4 + h) * 128 + r * 8) = pack8(o[h]);
  }
}

template <int GRP>
DI void ln_items(float* X, const float* gam, const float* bet, bf16_t* u2, const float* sc, const float* sh, int item0) {
  const int tid = TIDX(), lane = tid & 63, wave = tid >> 6;
  f32x4 v[GRP][4];
#pragma unroll
  for (int g = 0; g < GRP; ++g) {
    const size_t tok = (size_t)(item0 + g) * 4 + wave;
#pragma unroll
    for (int j = 0; j < 4; ++j) v[g][j] = *(const f32x4*)(X + tok * 1024 + j * 256 + lane * 4);
  }
#pragma unroll
  for (int g = 0; g < GRP; ++g) {
    const size_t tok = (size_t)(item0 + g) * 4 + wave;
    const int b = (int)(tok >> 13);
    float s = 0.f;
#pragma unroll
    for (int j = 0; j < 4; ++j) s += v[g][j][0] + v[g][j][1] + v[g][j][2] + v[g][j][3];
#pragma unroll
    for (int off = 32; off >= 1; off >>= 1) s += __shfl_xor(s, off);
    const float mu = s * (1.f / 1024.f);
    float q = 0.f;
#pragma unroll
    for (int j = 0; j < 4; ++j)
#pragma unroll
      for (int e = 0; e < 4; ++e) { const float d = v[g][j][e] - mu; q += d * d; }
#pragma unroll
    for (int off = 32; off >= 1; off >>= 1) q += __shfl_xor(q, off);
    const float rstd = rsqrtf(q * (1.f / 1024.f) + 1e-5f);
#pragma unroll
    for (int j = 0; j < 4; ++j) {
      const int col = j * 256 + lane * 4;
      const f32x4 gg = *(const f32x4*)(gam + col), be = *(const f32x4*)(bet + col);
      f32x4 y;
#pragma unroll
      for (int e = 0; e < 4; ++e) y[e] = (v[g][j][e] - mu) * rstd * gg[e] + be[e];
      *(f32x4*)(X + tok * 1024 + col) = y;
      if (u2) {
        const f32x4 s4 = *(const f32x4*)(sc + b * 6144 + col), h4 = *(const f32x4*)(sh + b * 6144 + col);
        uint2 o;
        o.x = pack2(y[0] * (1.f + s4[0]) + h4[0], y[1] * (1.f + s4[1]) + h4[1]);
        o.y = pack2(y[2] * (1.f + s4[2]) + h4[2], y[3] * (1.f + s4[3]) + h4[3]);
        *(uint2*)(u2 + tok * 1024 + col) = o;
      }
    }
  }
}

enum { PH_PRO = 0, PH_U1, PH_INPROJ, PH_SEL, PH_SSMA, PH_ATTN, PH_SSMB, PH_CHA, PH_CHB, PH_COUNT };

DI void run_phase(const P& p, int ph, int l, int bid, int nblk, char* smem) {
  const float* modl = p.mod + (size_t)l * 8 * 6144;
  const bf16_t* wl = p.wT + (size_t)l * WO_LAYER;
  const float* xin = (l == 0) ? p.x : p.out;
  switch (ph) {
    case PH_PRO:
      for (int it = bid; it < N_PRO; it += nblk) prologue_item(p, it, smem);
      break;
    case PH_U1:
      for (int it = bid; it < NTOK / 2; it += nblk) {
        const size_t e0 = (size_t)it * 2048 + TIDX() * 8;
        const int b = (int)(e0 >> 23), col = (int)(e0 & 1023);
        const float4 x0 = *(const float4*)(xin + e0), x1 = *(const float4*)(xin + e0 + 4);
        const float4 s0 = *(const float4*)(modl + b * 6144 + 1024 + col), s1 = *(const float4*)(modl + b * 6144 + 1024 + col + 4);
        const float4 h0 = *(const float4*)(modl + b * 6144 + col), h1 = *(const float4*)(modl + b * 6144 + col + 4);
        uint4 r;
        r.x = pack2(x0.x * (1.f + s0.x) + h0.x, x0.y * (1.f + s0.y) + h0.y);
        r.y = pack2(x0.z * (1.f + s0.z) + h0.z, x0.w * (1.f + s0.w) + h0.w);
        r.z = pack2(x1.x * (1.f + s1.x) + h1.x, x1.y * (1.f + s1.y) + h1.y);
        r.w = pack2(x1.z * (1.f + s1.z) + h1.z, x1.w * (1.f + s1.w) + h1.w);
        *(uint4*)((bf16_t*)p.XA + e0) = r;
      }
      break;
    case PH_INPROJ: {
      ALoadBf16 al{(const bf16_t*)p.XA, 1024};
      EpiInproj epi{p};
      if ((nblk & 7) == 0) {
        const int x = bid & 7, j = bid >> 3, nj = nblk >> 3;
        for (int i = j; i < 64 * 19; i += nj) gemm_wide(al, wl + WO_IN, 1024, (x + 8 * (i / 19)) * 128, (i % 19) * 256, (i % 19) == 18 ? 1 : 2, smem, epi);
      } else {
        for (int it = bid; it < 512 * 19; it += nblk) gemm_wide(al, wl + WO_IN, 1024, (it / 19) * 128, (it % 19) * 256, (it % 19) == 18 ? 1 : 2, smem, epi);
      }
    } break;
    case PH_SEL:
      if ((nblk & 7) == 0) {
        const int b = bid & 7, j = bid >> 3, nj = nblk >> 3;
        SelPre sa, sb;
        if (j < 2048) select_prefetch(p, b, 2047 - j, sa);
        for (int i = j; i < 2048; i += nj) {
          const int inext = i + nj;
          if (inext < 2048) select_prefetch(p, b, 2047 - inext, sb);
          select_item(p, b, 2047 - i, bid, smem, sa);
          sa = sb;
        }
      } else {
        for (int it = bid; it < 16384; it += nblk) { SelPre sa; select_prefetch(p, it >> 11, 2047 - (it & 2047), sa); select_item(p, it >> 11, 2047 - (it & 2047), bid, smem, sa); }
      }
      break;
    case PH_SSMA:
      for (int it = bid; it < 4096; it += nblk) ssm_item<false>(p, l, it, smem);
      break;
    case PH_ATTN:
      if ((nblk & 7) == 0) {
        const int b = bid & 7, j = bid >> 3, nj = nblk >> 3;
        AttnPre pa, pb;
        if (j < 4096) attn_prefetch(p, b, j >> 11, j & 2047, pa);
        for (int i = j; i < 4096; i += nj) {
          const int inext = i + nj;
          if (inext < 4096) attn_prefetch(p, b, inext >> 11, inext & 2047, pb);
          attn_item(p, b, i >> 11, i & 2047, smem, pa);
          pa = pb;
        }
      } else {
        for (int it = bid; it < 32768; it += nblk) { AttnPre pa; attn_prefetch(p, it >> 12, (it >> 11) & 1, it & 2047, pa); attn_item(p, it >> 12, (it >> 11) & 1, it & 2047, smem, pa); }
      }
      break;
    case PH_SSMB:
      for (int it = bid; it < 4096; it += nblk) ssm_item<true>(p, l, it, smem);
      break;
    case PH_CHA: {
      ALoadBf16 aglu{p.y_pre, 512}, a1{p.y_ssm, 512}, a2{p.q, 1024}, aout{p.sg_s, 1024};
      EpiGlu eglu{p, p.b_glu + l * 512};
      EpiMerge1 e1{p}; EpiMerge2 e2{p};
      EpiResid eres{xin, modl + 2048, p.XA};
#pragma unroll 1
      for (int m = bid; m < 512; m += nblk) {
        const int m0 = m * 128;
#pragma unroll 1
        for (int n = 0; n < 2; ++n) gemm_wide(aglu, wl + WO_GLU, 512, m0, n * 256, 2, smem, eglu);
        __syncthreads();
#pragma unroll 1
        for (int n = 0; n < 4; ++n) {
          gemm_wide(a1, wl + WO_PSSM, 512, m0, n * 256, 2, smem, e1);
          gemm_wide(a2, wl + WO_PATTN, 1024, m0, n * 256, 2, smem, e2);
        }
        __syncthreads();
#pragma unroll 1
        for (int n = 0; n < 4; ++n) gemm_wide(aout, wl + WO_OUT, 1024, m0, n * 256, 2, smem, eres);
        __syncthreads();
#pragma unroll 1
        for (int i = 0; i < 32; i += 4) ln_items<4>(p.XA, p.ln1_g + l * 1024, p.ln1_b + l * 1024, p.u2, modl + 4096, modl + 3072, m * 32 + i);
        __syncthreads();
      }
    } break;
    case PH_CHB: {
      ALoadBf16 agu{p.u2, 1024}, adn{p.act, DFF};
      EpiGateUp egu{p};
      EpiResid eres{p.XA, modl + 5120, p.out};
#pragma unroll 1
      for (int m = bid; m < 512; m += nblk) {
        const int m0 = m * 128;
#pragma unroll 1
        for (int n = 0; n < 22; ++n) gemm_wide(agu, wl + WO_GU, 1024, m0, ((n + (m & 3)) % 22) * 256, 2, smem, egu);
        __syncthreads();
#pragma unroll 1
        for (int n = 0; n < 4; ++n) gemm_wide(adn, wl + WO_DOWN, DFF, m0, n * 256, 2, smem, eres);
        __syncthreads();
#pragma unroll 1
        for (int i = 0; i < 32; i += 4) ln_items<4>(p.out, p.ln2_g + l * 1024, p.ln2_b + l * 1024, nullptr, nullptr, nullptr, m * 32 + i);
        __syncthreads();
      }
    } break;
  }
}

template <int PH> __global__ void __launch_bounds__(256, 2) k_phase(P p, int l) {
  extern __shared__ __attribute__((aligned(16))) char smem[];
  run_phase(p, PH, l, blockIdx.x, gridDim.x, smem);
}
template <int PH> static void launch_phase(const P& p, int l, int G, hipStream_t stream) {
  static bool attr = false;
  if (!attr) { attr = true; (void)hipFuncSetAttribute((const void*)k_phase<PH>, hipFuncAttributeMaxDynamicSharedMemorySize, LDS_BYTES); }
  hipLaunchKernelGGL((k_phase<PH>), dim3(G), dim3(256), LDS_BYTES, stream, p, l);
}

#if MEGA
__global__ void __launch_bounds__(256, 2) k_mega(P p) {
  extern __shared__ __attribute__((aligned(16))) char smem[];
  cg::grid_group grid = cg::this_grid();
  run_phase(p, PH_PRO, 0, blockIdx.x, gridDim.x, smem);
  grid.sync();
#pragma unroll 1
  for (int l = 0; l < 2; ++l) {
#pragma unroll 1
    for (int ph = PH_U1; ph < PH_COUNT; ++ph) {
      run_phase(p, ph, l, blockIdx.x, gridDim.x, smem);
      if (!(l == 1 && ph == PH_CHB)) grid.sync();
    }
  }
}
#endif


extern "C" void kernel_launch(void* const* d_in, const int* in_sizes, int n_in, void* d_out, int out_size, void* d_ws, size_t ws_size, hipStream_t stream) {
  constexpr size_t MiB = 1ull << 20;
  size_t off = 0;
  auto take = [&](size_t bytes) { size_t o = off; off += (bytes + 255) & ~(size_t)255; return o; };
  const size_t o_wT = take(2 * WO_LAYER * 2);
  const size_t o_rope128 = take(8192 * 64 * 8), o_rope64 = take(8192 * 32 * 8);
  const size_t o_ssmA = take(2 * 32 * 64 * 16), o_ssmB = take(2 * 32 * 64 * 16 * 8), o_mod = take(2 * 8 * 6144 * 4), o_E = take((size_t)8 * 32 * 64 * 64 * 8);
  const size_t o_XA = take((size_t)NTOK * 1024 * 4);
  const size_t o_sel = take((size_t)NTOK * 256 * 2);
  const size_t o_P = off;
  const size_t o_ussm = take((size_t)NTOK * 512 * 2), o_q = take((size_t)NTOK * 1024 * 2), o_k = take((size_t)NTOK * 256 * 2), o_v = take((size_t)NTOK * 256 * 2);
  const size_t o_qidx = take((size_t)NTOK * 512 * 2), o_kidx = take((size_t)NTOK * 64 * 2), o_widx = take((size_t)NTOK * 8 * 4);
  const size_t o_sgs = take((size_t)NTOK * 1024 * 2), o_sga = take((size_t)NTOK * 1024 * 2);
  const size_t o_scr = take((size_t)512 * 4 * 8192 * 4);
  const size_t total = off;
  static int state = 0, grid_blocks = 0;
  if (state == 0) {
    state = 1;
    if (n_in != 24 || out_size != NTOK * 1024 || ws_size < total) {
      fprintf(stderr, "kernel_launch: unexpected sizes n_in %d out %d ws %zu (need %zu)\n", n_in, out_size, ws_size, total);
      state = -1;
    } else {
      int dev = 0, cus = 0, per_cu = 0;
      hipGetDevice(&dev);
      hipDeviceGetAttribute(&cus, hipDeviceAttributeMultiprocessorCount, dev);
#if MEGA
      hipFuncSetAttribute((const void*)k_mega, hipFuncAttributeMaxDynamicSharedMemorySize, LDS_BYTES);
      hipOccupancyMaxActiveBlocksPerMultiprocessor(&per_cu, (const void*)k_mega, 256, LDS_BYTES);
#endif
      if (per_cu < 1) per_cu = 1;
      if (per_cu > 2) per_cu = 2;
      grid_blocks = cus * per_cu;
      if (grid_blocks > 512) grid_blocks = 512;
      (void)hipGetLastError();
    }
  }
  if (state < 0) return;
  (void)MiB; (void)in_sizes;
  char* ws = (char*)d_ws;
  P p{};
  const float** f = (const float**)&p;
  for (int i = 0; i < 24; ++i) f[i] = (const float*)d_in[i];
  p.out = (float*)d_out;
  p.wT = (bf16_t*)(ws + o_wT);
  p.rope128 = (float2*)(ws + o_rope128); p.rope64 = (float2*)(ws + o_rope64);
  p.ssmA = (float4*)(ws + o_ssmA); p.ssmB = (float2*)(ws + o_ssmB); p.mod = (float*)(ws + o_mod); p.E = (float2*)(ws + o_E);
  p.XA = (float*)(ws + o_XA);
  p.sel = (unsigned short*)(ws + o_sel);
  p.scr = (unsigned*)(ws + o_scr);
  p.u_ssm = (bf16_t*)(ws + o_ussm); p.q = (bf16_t*)(ws + o_q); p.k = (bf16_t*)(ws + o_k); p.v = (bf16_t*)(ws + o_v);
  p.k8 = (unsigned char*)(ws + o_k); p.v8 = (unsigned char*)(ws + o_v);
  p.qidx = (bf16_t*)(ws + o_qidx); p.kidx = (bf16_t*)(ws + o_kidx); p.widx = (float*)(ws + o_widx);
  p.sg_s = (bf16_t*)(ws + o_sgs); p.sg_a = (bf16_t*)(ws + o_sga);
  p.y_pre = p.qidx;
  p.y_ssm = p.u_ssm;
  p.act = (bf16_t*)(ws + o_sel);
  p.u2 = p.sg_a;
#if MEGA
  void* args[] = {&p};
  hipError_t e = hipLaunchCooperativeKernel((const void*)k_mega, dim3(grid_blocks), dim3(256), args, LDS_BYTES, stream);
  if (e != hipSuccess) fprintf(stderr, "cooperative launch failed: %s (grid %d)\n", hipGetErrorString(e), grid_blocks);
#else
  const int G = 2048;
  launch_phase<PH_PRO>(p, 0, G, stream);
  for (int l = 0; l < 2; ++l) {
    launch_phase<PH_U1>(p, l, G, stream); launch_phase<PH_INPROJ>(p, l, G, stream); launch_phase<PH_SEL>(p, l, G, stream);
    launch_phase<PH_SSMA>(p, l, G, stream); launch_phase<PH_ATTN>(p, l, G, stream); launch_phase<PH_SSMB>(p, l, G, stream);
    launch_phase<PH_CHA>(p, l, G, stream); launch_phase<PH_CHB>(p, l, G, stream);
  }
#endif
}
```

```cpp
#include <hip/hip_runtime.h>
#include <hip/hip_cooperative_groups.h>
#include <cstdio>
#include <cstdint>
namespace cg = cooperative_groups;

#ifndef DIAG_PSEUDO
#define DIAG_PSEUDO 0
#endif
#ifndef DIAG_SCALE
#define DIAG_SCALE 0
#endif
#ifndef MEGA
#define MEGA 1
#endif

typedef unsigned short bf16_t;
typedef short bf16x8 __attribute__((ext_vector_type(8)));
typedef float f32x4 __attribute__((ext_vector_type(4)));
typedef float f32x16 __attribute__((ext_vector_type(16)));
typedef unsigned u32x4 __attribute__((ext_vector_type(4)));
typedef unsigned u32x2 __attribute__((ext_vector_type(2)));
#define DI __device__ __forceinline__

constexpr int SEQ = 8192, NB = 8, DM = 1024, NTOK = NB * SEQ;
constexpr int DINP = 4736;
constexpr int DFF = 2816;
constexpr float ALPHA = 1.41421356237f;
constexpr float IDX_SCALE = 0.04419417382415922f;
constexpr float ATT_SCALE = 0.08838834764831845f;
constexpr int LDS_BYTES = 77824;

constexpr size_t WO_IN = 0, WO_GLU = WO_IN + (size_t)4864 * 1024, WO_PSSM = WO_GLU + 512 * 512, WO_PATTN = WO_PSSM + 1024 * 512,
                 WO_OUT = WO_PATTN + 1024 * 1024, WO_GU = WO_OUT + 1024 * 1024, WO_DOWN = WO_GU + (size_t)5632 * 1024, WO_LAYER = WO_DOWN + (size_t)1024 * DFF;

struct P {
  const float *x, *c, *w_cond, *b_cond, *w_in, *lam_re, *lam_im, *log_dt, *b_re, *b_im, *c_re, *c_im, *d_skip, *w_glu, *b_glu, *p_ssm, *p_attn, *w_out,
      *ln1_g, *ln1_b, *w_gu, *w_down, *ln2_g, *ln2_b;
  float* out;
  bf16_t* wT;
  float2* rope128;
  float2* rope64;
  float4* ssmA;
  float2* ssmB;
  float* mod;
  float2* E;
  float* XA;
  bf16_t *u_ssm, *q, *k, *v, *qidx, *kidx;
  unsigned char *k8, *v8;
  float* widx;
  bf16_t *sg_s, *sg_a;
  unsigned short* sel;
  unsigned* scr;
  bf16_t *y_pre, *y_ssm, *act, *u2;
};

DI int TIDX() { int t = __builtin_amdgcn_workitem_id_x(); asm volatile("" : "+v"(t)); return t; }
DI float bf2f(bf16_t h) { return __uint_as_float(((unsigned)h) << 16); }
DI bf16_t f2bf(float x) { return __builtin_bit_cast(bf16_t, (__bf16)x); }
typedef __bf16 hwbf16x2 __attribute__((ext_vector_type(2)));
typedef float hwf32x2 __attribute__((ext_vector_type(2)));
DI unsigned pack2(float a, float b) { const hwf32x2 f = {a, b}; return __builtin_bit_cast(unsigned, __builtin_convertvector(f, hwbf16x2)); }
DI float sigm(float x) { return __builtin_amdgcn_rcpf(1.f + __expf(-x)); }
DI uint2 pack8_fp8(const float* v) {
  int w0 = 0, w1 = 0;
  w0 = __builtin_amdgcn_cvt_pk_fp8_f32(v[0], v[1], w0, false); w0 = __builtin_amdgcn_cvt_pk_fp8_f32(v[2], v[3], w0, true);
  w1 = __builtin_amdgcn_cvt_pk_fp8_f32(v[4], v[5], w1, false); w1 = __builtin_amdgcn_cvt_pk_fp8_f32(v[6], v[7], w1, true);
  uint2 r; r.x = (unsigned)w0; r.y = (unsigned)w1; return r;
}
typedef float f32x2_t __attribute__((ext_vector_type(2)));
DI void fp8x4_to_bf16x4(unsigned w, unsigned& lo, unsigned& hi) {
  const f32x2_t a = __builtin_amdgcn_cvt_pk_f32_fp8((int)w, false), b = __builtin_amdgcn_cvt_pk_f32_fp8((int)w, true);
  lo = (__float_as_uint(a.x) >> 16) | (__float_as_uint(a.y) & 0xffff0000u);
  hi = (__float_as_uint(b.x) >> 16) | (__float_as_uint(b.y) & 0xffff0000u);
}
DI uint4 pack8(const float* v) { uint4 r; r.x = pack2(v[0], v[1]); r.y = pack2(v[2], v[3]); r.z = pack2(v[4], v[5]); r.w = pack2(v[6], v[7]); return r; }

struct ALoadBf16 {
  const bf16_t* A; int lda;
  DI u32x4 load(int row, int k) const { return *(const u32x4*)(A + (size_t)row * lda + k); }
};
struct ALoadXMod {
  const float* x; const float* sc; const float* sh;
  DI u32x4 load(int row, int k) const {
    const int b = row >> 13;
    const float4* xp = (const float4*)(x + (size_t)row * 1024 + k);
    const float4* sp = (const float4*)(sc + b * 6144 + k);
    const float4* hp = (const float4*)(sh + b * 6144 + k);
    float4 x0 = xp[0], x1 = xp[1], s0 = sp[0], s1 = sp[1], h0 = hp[0], h1 = hp[1];
    u32x4 r;
    r.x = pack2(x0.x * (1.f + s0.x) + h0.x, x0.y * (1.f + s0.y) + h0.y);
    r.y = pack2(x0.z * (1.f + s0.z) + h0.z, x0.w * (1.f + s0.w) + h0.w);
    r.z = pack2(x1.x * (1.f + s1.x) + h1.x, x1.y * (1.f + s1.y) + h1.y);
    r.w = pack2(x1.z * (1.f + s1.z) + h1.z, x1.w * (1.f + s1.w) + h1.w);
    return r;
  }
};

constexpr int LDT = 72;
constexpr int LDC = 132;

template <class AL, class EPI>
DI void gemm_tile(const AL& al, const bf16_t* __restrict__ Bt, int K, int m0, int n0, char* smem, const EPI& epi) {
  bf16_t* As = (bf16_t*)smem;
  bf16_t* Bs = As + 128 * LDT;
  float* Cs = (float*)smem;
  const int tid = TIDX(), lane = tid & 63, wave = tid >> 6, wm = wave >> 1, wn = wave & 1;
  const int lr = lane & 31, lh = lane >> 5;
  f32x16 acc[2][2];
#pragma unroll
  for (int i = 0; i < 2; ++i)
#pragma unroll
    for (int j = 0; j < 2; ++j)
#pragma unroll
      for (int r = 0; r < 16; ++r) acc[i][j][r] = 0.f;
  u32x4 ra[4], rb[4];
  const int nkt = K >> 6;
#pragma unroll
  for (int i = 0; i < 4; ++i) {
    const int c = tid + 256 * i, row = c >> 3, kc = (c & 7) * 8;
    ra[i] = al.load(m0 + row, kc);
    rb[i] = *(const u32x4*)(Bt + (size_t)(n0 + row) * K + kc);
  }
  for (int kt = 0; kt < nkt; ++kt) {
    __syncthreads();
#pragma unroll
    for (int i = 0; i < 4; ++i) {
      const int c = tid + 256 * i, row = c >> 3, kc = (c & 7) * 8;
      *(u32x4*)(As + row * LDT + kc) = ra[i];
      *(u32x4*)(Bs + row * LDT + kc) = rb[i];
    }
    __syncthreads();
    if (kt + 1 < nkt) {
      const int k0 = (kt + 1) << 6;
#pragma unroll
      for (int i = 0; i < 4; ++i) {
        const int c = tid + 256 * i, row = c >> 3, kc = (c & 7) * 8;
        ra[i] = al.load(m0 + row, k0 + kc);
        rb[i] = *(const u32x4*)(Bt + (size_t)(n0 + row) * K + k0 + kc);
      }
    }
#pragma unroll
    for (int ks = 0; ks < 4; ++ks) {
      bf16x8 a[2], b[2];
#pragma unroll
      for (int i = 0; i < 2; ++i) a[i] = *(const bf16x8*)(As + (wm * 64 + i * 32 + lr) * LDT + ks * 16 + lh * 8);
#pragma unroll
      for (int j = 0; j < 2; ++j) b[j] = *(const bf16x8*)(Bs + (wn * 64 + j * 32 + lr) * LDT + ks * 16 + lh * 8);
#pragma unroll
      for (int i = 0; i < 2; ++i)
#pragma unroll
        for (int j = 0; j < 2; ++j) acc[i][j] = __builtin_amdgcn_mfma_f32_32x32x16_bf16(a[i], b[j], acc[i][j], 0, 0, 0);
    }
  }
  __syncthreads();
#pragma unroll
  for (int i = 0; i < 2; ++i)
#pragma unroll
    for (int j = 0; j < 2; ++j)
#pragma unroll
      for (int r = 0; r < 16; ++r) {
        const int row = wm * 64 + i * 32 + (r & 3) + 8 * (r >> 2) + 4 * lh, col = wn * 64 + j * 32 + lr;
        Cs[row * LDC + col] = acc[i][j][r];
      }
  __syncthreads();
  epi(Cs, m0, n0);
}


template <class AL, class EPI>
DI void gemm_wide(const AL& al, const bf16_t* __restrict__ Bt, int K, int m0, int n0, int nhalf, char* smem, const EPI& epi) {
  bf16_t* As = (bf16_t*)smem;
  bf16_t* Bs = As + 128 * LDT;
  float* Cs = (float*)smem;
  const int tid = TIDX(), lane = tid & 63, wave = tid >> 6, wm = wave >> 1, wn = wave & 1;
  const int lr = lane & 31, lh = lane >> 5;
  f32x16 acc[2][4];
#pragma unroll
  for (int i = 0; i < 2; ++i)
#pragma unroll
    for (int j = 0; j < 4; ++j)
#pragma unroll
      for (int r = 0; r < 16; ++r) acc[i][j][r] = 0.f;
  u32x4 ra[4], rb[8];
  const int nkt = K >> 6;
#pragma unroll
  for (int i = 0; i < 8; ++i) {
    const int c = tid + 256 * i, row = c >> 3, kc = (c & 7) * 8;
    if (i < 4) ra[i] = al.load(m0 + row, kc);
    rb[i] = *(const u32x4*)(Bt + (size_t)(n0 + row) * K + kc);
  }
#pragma unroll 1
  for (int kt = 0; kt < nkt; ++kt) {
    __syncthreads();
#pragma unroll
    for (int i = 0; i < 8; ++i) {
      const int c = tid + 256 * i, row = c >> 3, kc = (c & 7) * 8;
      if (i < 4) *(u32x4*)(As + row * LDT + kc) = ra[i];
      *(u32x4*)(Bs + row * LDT + kc) = rb[i];
    }
    __syncthreads();
    if (kt + 1 < nkt) {
      const int k0 = (kt + 1) << 6;
#pragma unroll
      for (int i = 0; i < 8; ++i) {
        const int c = tid + 256 * i, row = c >> 3, kc = (c & 7) * 8;
        if (i < 4) ra[i] = al.load(m0 + row, k0 + kc);
        rb[i] = *(const u32x4*)(Bt + (size_t)(n0 + row) * K + k0 + kc);
      }
    }
    {
      bf16x8 a[2][2], b[2][4];
#pragma unroll
      for (int i = 0; i < 2; ++i) a[0][i] = *(const bf16x8*)(As + (wm * 64 + i * 32 + lr) * LDT + lh * 8);
#pragma unroll
      for (int j = 0; j < 4; ++j) b[0][j] = *(const bf16x8*)(Bs + (wn * 128 + j * 32 + lr) * LDT + lh * 8);
#pragma unroll
      for (int ks = 0; ks < 4; ++ks) {
        if (ks + 1 < 4) {
#pragma unroll
          for (int i = 0; i < 2; ++i) a[(ks + 1) & 1][i] = *(const bf16x8*)(As + (wm * 64 + i * 32 + lr) * LDT + (ks + 1) * 16 + lh * 8);
#pragma unroll
          for (int j = 0; j < 4; ++j) b[(ks + 1) & 1][j] = *(const bf16x8*)(Bs + (wn * 128 + j * 32 + lr) * LDT + (ks + 1) * 16 + lh * 8);
        }
#pragma unroll
        for (int i = 0; i < 2; ++i)
#pragma unroll
          for (int j = 0; j < 4; ++j) acc[i][j] = __builtin_amdgcn_mfma_f32_32x32x16_bf16(a[ks & 1][i], b[ks & 1][j], acc[i][j], 0, 0, 0);
        if (ks + 1 < 4) {
#pragma unroll
          for (int g = 0; g < 6; ++g) {
            __builtin_amdgcn_sched_group_barrier(0x100, 1, 0);
            __builtin_amdgcn_sched_group_barrier(0x008, 1, 0);
          }
          __builtin_amdgcn_sched_group_barrier(0x008, 2, 0);
        } else {
          __builtin_amdgcn_sched_group_barrier(0x008, 8, 0);
        }
      }
    }
  }
#pragma unroll
  for (int half = 0; half < 2; ++half) {
    __syncthreads();
    if (wn == half) {
#pragma unroll
      for (int i = 0; i < 2; ++i)
#pragma unroll
        for (int j = 0; j < 4; ++j)
#pragma unroll
          for (int r = 0; r < 16; ++r) {
            const int row = wm * 64 + i * 32 + (r & 3) + 8 * (r >> 2) + 4 * lh, col = j * 32 + lr;
            Cs[row * LDC + col] = acc[i][j][r];
          }
    }
    __syncthreads();
    if (half < nhalf) epi(Cs, m0, n0 + 128 * half);
  }
}

struct EpiInproj {
  const P& p;
  DI void operator()(const float* Cs, int m0, int n0) const {
    const int nt = n0 >> 7, tid = TIDX();
#pragma unroll 1
    for (int pass = 0; pass < 8; ++pass) {
      const int row = pass * 16 + (tid >> 4), c8 = (tid & 15) * 8;
      const size_t tok = (size_t)(m0 + row);
      const int pos = (int)(tok & 8191);
      const float* cr = Cs + row * LDC;
      float v[8];
      if (nt < 4) {
#pragma unroll
        for (int e = 0; e < 8; ++e) v[e] = cr[c8 + e];
        *(uint4*)(p.u_ssm + tok * 512 + nt * 128 + c8) = pack8(v);
      } else if (nt < 14) {
        const float2* rt = p.rope128 + pos * 64;
        if (c8 < 64) {
#pragma unroll
          for (int e = 0; e < 8; ++e) { const int c = c8 + e; const float2 cs = rt[c]; v[e] = cr[c] * cs.x - cr[c + 64] * cs.y; }
        } else {
#pragma unroll
          for (int e = 0; e < 8; ++e) { const int c = c8 + e, cc = c - 64; const float2 cs = rt[cc]; v[e] = cr[c] * cs.x + cr[cc] * cs.y; }
        }
        if (nt < 12) *(uint4*)(p.q + tok * 1024 + (nt - 4) * 128 + c8) = pack8(v);
        else *(uint2*)(p.k8 + tok * 256 + (nt - 12) * 128 + c8) = pack8_fp8(v);
      } else if (nt < 16) {
#pragma unroll
        for (int e = 0; e < 8; ++e) v[e] = cr[c8 + e];
        *(uint2*)(p.v8 + tok * 256 + (nt - 14) * 128 + c8) = pack8_fp8(v);
      } else if (nt < 20 || (nt == 20 && c8 < 64)) {
        const float2* rt = p.rope64 + pos * 32;
        const int cl = c8 & 63;
        if (cl < 32) {
#pragma unroll
          for (int e = 0; e < 8; ++e) { const int c = c8 + e; const float2 cs = rt[cl + e]; v[e] = cr[c] * cs.x - cr[c + 32] * cs.y; }
        } else {
#pragma unroll
          for (int e = 0; e < 8; ++e) { const int c = c8 + e; const float2 cs = rt[cl + e - 32]; v[e] = cr[c] * cs.x + cr[c - 32] * cs.y; }
        }
        bf16_t* dst = (nt < 20) ? (p.qidx + tok * 512 + (nt - 16) * 128 + c8) : (p.kidx + tok * 64 + c8);
        *(uint4*)dst = pack8(v);
      } else if (nt == 20) {
        if (c8 == 64) {
          float4 w0, w1;
          w0.x = cr[64] * IDX_SCALE; w0.y = cr[65] * IDX_SCALE; w0.z = cr[66] * IDX_SCALE; w0.w = cr[67] * IDX_SCALE;
          w1.x = cr[68] * IDX_SCALE; w1.y = cr[69] * IDX_SCALE; w1.z = cr[70] * IDX_SCALE; w1.w = cr[71] * IDX_SCALE;
          *(float4*)(p.widx + tok * 8) = w0; *(float4*)(p.widx + tok * 8 + 4) = w1;
        }
      } else {
#pragma unroll
        for (int e = 0; e < 8; ++e) v[e] = sigm(cr[c8 + e]);
        bf16_t* dst = (nt < 29) ? (p.sg_s + tok * 1024 + (nt - 21) * 128 + c8) : (p.sg_a + tok * 1024 + (nt - 29) * 128 + c8);
        *(uint4*)dst = pack8(v);
      }
    }
  }
};

struct EpiGlu {
  const P& p; const float* bglu;
  DI void operator()(const float* Cs, int m0, int n0) const {
    const int tid = TIDX(), c8 = (tid & 15) * 8, r0 = tid >> 4;
    u32x4 yr[8];
#pragma unroll
    for (int pass = 0; pass < 8; ++pass) yr[pass] = *(const u32x4*)(p.y_pre + (size_t)(m0 + pass * 16 + r0) * 512 + n0 + c8);
    float bg[8];
#pragma unroll
    for (int e = 0; e < 8; ++e) bg[e] = bglu[n0 + c8 + e];
#pragma unroll
    for (int pass = 0; pass < 8; ++pass) {
      const int row = pass * 16 + r0;
      const float* cr = Cs + row * LDC + c8;
      float v[8];
#pragma unroll
      for (int e = 0; e < 8; ++e) {
        const unsigned w = yr[pass][e >> 1];
        const float y = __uint_as_float((e & 1) ? (w & 0xffff0000u) : (w << 16));
        v[e] = y * sigm(cr[e] + bg[e]);
      }
      *(uint4*)(p.y_ssm + (size_t)(m0 + row) * 512 + n0 + c8) = pack8(v);
    }
  }
};

struct EpiMerge1 {
  const P& p;
  DI void operator()(const float* Cs, int m0, int n0) const {
    const int tid = TIDX(), c8 = (tid & 15) * 8, r0 = tid >> 4;
    u32x4 gr[8];
#pragma unroll
    for (int pass = 0; pass < 8; ++pass) gr[pass] = *(const u32x4*)(p.sg_s + (size_t)(m0 + pass * 16 + r0) * 1024 + n0 + c8);
#pragma unroll
    for (int pass = 0; pass < 8; ++pass) {
      const int row = pass * 16 + r0;
      const float* cr = Cs + row * LDC + c8;
      float v[8];
#pragma unroll
      for (int e = 0; e < 8; ++e) {
        const unsigned w = gr[pass][e >> 1];
        const float g = __uint_as_float((e & 1) ? (w & 0xffff0000u) : (w << 16));
        v[e] = g * cr[e];
      }
      *(uint4*)(p.sg_s + (size_t)(m0 + row) * 1024 + n0 + c8) = pack8(v);
    }
  }
};
struct EpiMerge2 {
  const P& p;
  DI void operator()(const float* Cs, int m0, int n0) const {
    const int tid = TIDX(), c8 = (tid & 15) * 8, r0 = tid >> 4;
    u32x4 gr[8], pr[8];
#pragma unroll
    for (int pass = 0; pass < 8; ++pass) {
      gr[pass] = *(const u32x4*)(p.sg_a + (size_t)(m0 + pass * 16 + r0) * 1024 + n0 + c8);
      pr[pass] = *(const u32x4*)(p.sg_s + (size_t)(m0 + pass * 16 + r0) * 1024 + n0 + c8);
    }
#pragma unroll
    for (int pass = 0; pass < 8; ++pass) {
      const int row = pass * 16 + r0;
      const float* cr = Cs + row * LDC + c8;
      float v[8];
#pragma unroll
      for (int e = 0; e < 8; ++e) {
        const unsigned wg = gr[pass][e >> 1], wp = pr[pass][e >> 1];
        const float g = __uint_as_float((e & 1) ? (wg & 0xffff0000u) : (wg << 16));
        const float pa = __uint_as_float((e & 1) ? (wp & 0xffff0000u) : (wp << 16));
        v[e] = pa + g * cr[e];
      }
      *(uint4*)(p.sg_s + (size_t)(m0 + row) * 1024 + n0 + c8) = pack8(v);
    }
  }
};
struct EpiResid {
  const float* xin; const float* gt; float* dst;
  DI void operator()(const float* Cs, int m0, int n0) const {
    const int tid = TIDX(), c8 = (tid & 15) * 8, r0 = tid >> 4;
    const int b = m0 >> 13;
    f32x4 xa[8], xb[8];
#pragma unroll
    for (int pass = 0; pass < 8; ++pass) {
      const f32x4* xs = (const f32x4*)(xin + (size_t)(m0 + pass * 16 + r0) * 1024 + n0 + c8);
      xa[pass] = xs[0]; xb[pass] = xs[1];
    }
    const f32x4* gs = (const f32x4*)(gt + b * 6144 + n0 + c8);
    const f32x4 g0 = gs[0], g1 = gs[1];
#pragma unroll
    for (int pass = 0; pass < 8; ++pass) {
      const int row = pass * 16 + r0;
      const float* cr = Cs + row * LDC + c8;
      f32x4 o0, o1;
#pragma unroll
      for (int e = 0; e < 4; ++e) { o0[e] = ALPHA * xa[pass][e] + (1.f + g0[e]) * cr[e]; o1[e] = ALPHA * xb[pass][e] + (1.f + g1[e]) * cr[4 + e]; }
      f32x4* d = (f32x4*)(dst + (size_t)(m0 + row) * 1024 + n0 + c8);
      d[0] = o0; d[1] = o1;
    }
  }
};
struct EpiGateUp {
  const P& p;
  DI void operator()(const float* Cs, int m0, int n0) const {
    const int tid = TIDX(), j = n0 >> 7;
#pragma unroll 1
    for (int pass = 0; pass < 4; ++pass) {
      const int row = pass * 32 + (tid >> 3), c8 = (tid & 7) * 8;
      const size_t tok = (size_t)(m0 + row);
      const float* cr = Cs + row * LDC + c8;
      float v[8];
#pragma unroll
      for (int e = 0; e < 8; ++e) { const float a = cr[e], bb = cr[64 + e]; v[e] = a * sigm(a) * bb; }
      *(uint4*)(p.act + tok * DFF + j * 64 + c8) = pack8(v);
    }
  }
};

DI int colmap(int mode, int n) {
  if (mode == 0) return n;
  if (mode == 1) return n < 2632 ? n : (n < 2688 ? -1 : (n < 4736 ? n - 56 : -1));
  const int j = n >> 7, r = n & 127;
  return r < 64 ? (64 * j + r) : (2816 + 64 * j + (r - 64));
}
DI void transpose_item(const float* __restrict__ src, int K, int Ns, bf16_t* __restrict__ dst, int mode, int item, char* smem) {
  float* T = (float*)smem;
  const int nkt = K >> 6, kt = item % nkt, nt = item / nkt, k0 = kt * 64, n0 = nt * 64, tid = TIDX();
  __syncthreads();
  {
    const int n = n0 + (tid & 63), sc = colmap(mode, n);
#pragma unroll 4
    for (int rr = 0; rr < 16; ++rr) {
      const int r = rr * 4 + (tid >> 6);
      T[r * 65 + (tid & 63)] = sc >= 0 ? src[(size_t)(k0 + r) * Ns + sc] : 0.f;
    }
  }
  __syncthreads();
#pragma unroll 4
  for (int rr = 0; rr < 16; ++rr) {
    const int nn = rr * 4 + (tid >> 6);
    dst[(size_t)(n0 + nn) * K + k0 + (tid & 63)] = f2bf(T[(tid & 63) * 65 + nn]);
  }
}

constexpr int TR_IN = 76 * 16, TR_GLU = 64, TR_PSSM = 16 * 8, TR_PATTN = 256, TR_OUT = 256, TR_GU = 88 * 16, TR_DOWN = 16 * 44;
constexpr int TR_LAYER = TR_IN + TR_GLU + TR_PSSM + TR_PATTN + TR_OUT + TR_GU + TR_DOWN;
constexpr int N_TR = 2 * TR_LAYER, N_COND = 2 * 192, N_ROPE = 8192 / 8, N_SSMT = (2 * 32 * 64) / 256;
constexpr int N_PRO = N_TR + N_COND + N_ROPE + N_SSMT;

DI void prologue_item(const P& p, int item, char* smem) {
  const int tid = TIDX();
  if (item < N_TR) {
    const int l = item / TR_LAYER; int it = item % TR_LAYER;
    bf16_t* wl = p.wT + (size_t)l * WO_LAYER;
    if (it < TR_IN) { transpose_item(p.w_in + (size_t)l * 1024 * 4680, 1024, 4680, wl + WO_IN, 1, it, smem); return; } it -= TR_IN;
    if (it < TR_GLU) { transpose_item(p.w_glu + (size_t)l * 512 * 512, 512, 512, wl + WO_GLU, 0, it, smem); return; } it -= TR_GLU;
    if (it < TR_PSSM) { transpose_item(p.p_ssm + (size_t)l * 512 * 1024, 512, 1024, wl + WO_PSSM, 0, it, smem); return; } it -= TR_PSSM;
    if (it < TR_PATTN) { transpose_item(p.p_attn + (size_t)l * 1024 * 1024, 1024, 1024, wl + WO_PATTN, 0, it, smem); return; } it -= TR_PATTN;
    if (it < TR_OUT) { transpose_item(p.w_out + (size_t)l * 1024 * 1024, 1024, 1024, wl + WO_OUT, 0, it, smem); return; } it -= TR_OUT;
    if (it < TR_GU) { transpose_item(p.w_gu + (size_t)l * 1024 * 5632, 1024, 5632, wl + WO_GU, 2, it, smem); return; } it -= TR_GU;
    transpose_item(p.w_down + (size_t)l * DFF * 1024, DFF, 1024, wl + WO_DOWN, 0, it, smem); return;
  }
  item -= N_TR;
  if (item < N_COND) {
    const int l = item / 192, n0 = (item % 192) * 32;
    float* sc = (float*)smem;
    float* red = sc + 8192;
    __syncthreads();
    for (int i = tid; i < 8192; i += 256) { const float cv = p.c[i]; sc[i] = cv * sigm(cv); }
    __syncthreads();
    const int nn = tid & 31, kc = tid >> 5;
    float acc[8];
#pragma unroll
    for (int b = 0; b < 8; ++b) acc[b] = 0.f;
    const float* wp = p.w_cond + ((size_t)l * 1024 + kc * 128) * 6144 + n0 + nn;
    for (int k = 0; k < 128; ++k) {
      const float w = wp[(size_t)k * 6144];
#pragma unroll
      for (int b = 0; b < 8; ++b) acc[b] += sc[b * 1024 + kc * 128 + k] * w;
    }
#pragma unroll
    for (int b = 0; b < 8; ++b) red[(kc * 8 + b) * 32 + nn] = acc[b];
    __syncthreads();
    {
      const int b = tid >> 5;
      float s = 0.f;
#pragma unroll
      for (int q = 0; q < 8; ++q) s += red[(q * 8 + b) * 32 + nn];
      p.mod[((size_t)l * 8 + b) * 6144 + n0 + nn] = s + p.b_cond[l * 6144 + n0 + nn];
    }
    return;
  }
  item -= N_COND;
  if (item < N_ROPE) {
#pragma unroll 1
    for (int k = 0; k < 3; ++k) {
      const int e = tid + 256 * k;
      const int pos = item * 8 + e / 96, j = e % 96;
      if (j < 64) {
        const float inv = (float)pow(10000.0, -(double)j / 64.0);
        const float ang = (float)pos * inv;
        p.rope128[pos * 64 + j] = make_float2((float)cos((double)ang), (float)sin((double)ang));
      } else {
        const int i = j - 64;
        const float inv = (float)pow(10000.0, -(double)i / 32.0);
        const float ang = (float)pos * inv;
        p.rope64[pos * 32 + i] = make_float2((float)cos((double)ang), (float)sin((double)ang));
      }
    }
    return;
  }
  item -= N_ROPE;
  {
    const int idx = item * 256 + tid;
    const int lg = idx >> 6;
    const double dt = exp((double)p.log_dt[lg]);
    const double lr = p.lam_re[idx], li = p.lam_im[idx];
    const double mag = exp(lr * dt), ar = mag * cos(li * dt), ai = mag * sin(li * dt);
    const double mag128 = exp(lr * dt * 128.0), ar128 = mag128 * cos(li * dt * 128.0), ai128 = mag128 * sin(li * dt * 128.0);
    const double den = lr * lr + li * li, nr = ar - 1.0;
    const double fr = (nr * lr + ai * li) / den, fi = (ai * lr - nr * li) / den;
    p.ssmA[idx] = make_float4((float)ar, (float)ai, (float)ar128, (float)ai128);
    for (int i = 0; i < 16; ++i) {
      const double br = p.b_re[(size_t)idx * 16 + i], bi = p.b_im[(size_t)idx * 16 + i];
      p.ssmB[(size_t)idx * 16 + i] = make_float2((float)(fr * br - fi * bi), (float)(fr * bi + fi * br));
    }
  }
}

template <bool FULL>
DI void ssm_item(const P& p, int l, int item, char* smem) {
  const int tid = TIDX(), lane = tid & 63, wave = tid >> 6;
  const int b = item >> 9, c = (item >> 3) & 63, g = (item & 7) * 4 + wave;
  float* H = (float*)smem + wave * (16 * 132 + 256);
  float* us = H + 16 * 132;
  const int lg = l * 32 + g;
  const float4 a4 = p.ssmA[lg * 64 + lane];
  const float ar = a4.x, ai = a4.y;
  float bbr[16], bbi[16];
  {
    const float4* bp = (const float4*)(p.ssmB + ((size_t)lg * 64 + lane) * 16);
#pragma unroll
    for (int i = 0; i < 8; ++i) { const float4 t = bp[i]; bbr[2 * i] = t.x; bbi[2 * i] = t.y; bbr[2 * i + 1] = t.z; bbi[2 * i + 1] = t.w; }
  }
  float hr = 0.f, hi = 0.f;
  const int ch = lane & 15, quad = lane >> 4;
  float creg[32];
  float dsk = 0.f;
  if (FULL) {
    const float2* Ep = p.E + ((size_t)(b * 32 + g) * 64) * 64 + lane;
    for (int cc = 0; cc < c; ++cc) {
      const float2 e = Ep[cc * 64];
      const float nhr = a4.z * hr - a4.w * hi + e.x, nhi = a4.z * hi + a4.w * hr + e.y;
      hr = nhr; hi = nhi;
    }
    const float* cp = (quad < 2 ? p.c_re : p.c_im) + ((size_t)lg * 16 + ch) * 64 + (quad & 1) * 32;
    const float sgn = quad < 2 ? 1.f : -1.f;
#pragma unroll
    for (int i = 0; i < 8; ++i) { const float4 t = ((const float4*)cp)[i]; creg[4 * i] = sgn * t.x; creg[4 * i + 1] = sgn * t.y; creg[4 * i + 2] = sgn * t.z; creg[4 * i + 3] = sgn * t.w; }
    dsk = p.d_skip[l * 512 + g * 16 + ch];
  }
  const size_t tok0 = (size_t)b * SEQ + c * 128;
  const int tt = lane >> 2, part = lane & 3;
  uint2 raw = *(const uint2*)(p.u_ssm + (tok0 + tt) * 512 + g * 16 + part * 4);
#pragma unroll 1
  for (int s = 0; s < 8; ++s) {
    float4 uf;
    uf.x = __uint_as_float(raw.x << 16); uf.y = __uint_as_float(raw.x & 0xffff0000u);
    uf.z = __uint_as_float(raw.y << 16); uf.w = __uint_as_float(raw.y & 0xffff0000u);
    __builtin_amdgcn_wave_barrier();
    *(float4*)(us + tt * 16 + part * 4) = uf;
    __builtin_amdgcn_wave_barrier();
    if (s + 1 < 8) raw = *(const uint2*)(p.u_ssm + (tok0 + (s + 1) * 16 + tt) * 512 + g * 16 + part * 4);
#pragma unroll 4
    for (int t = 0; t < 16; ++t) {
      const float4* up = (const float4*)(us + t * 16);
      const float4 u0 = up[0], u1 = up[1], u2 = up[2], u3 = up[3];
      const float uu[16] = {u0.x, u0.y, u0.z, u0.w, u1.x, u1.y, u1.z, u1.w, u2.x, u2.y, u2.z, u2.w, u3.x, u3.y, u3.z, u3.w};
      float br = 0.f, bi = 0.f;
#pragma unroll
      for (int i = 0; i < 16; ++i) { br = fmaf(bbr[i], uu[i], br); bi = fmaf(bbi[i], uu[i], bi); }
      const float nhr = ar * hr - ai * hi + br, nhi = ar * hi + ai * hr + bi;
      hr = nhr; hi = nhi;
      if (FULL) { H[t * 132 + lane] = hr; H[t * 132 + 64 + lane] = hi; }
    }
    if (FULL) {
      __builtin_amdgcn_wave_barrier();
      f32x4 acc = {0.f, 0.f, 0.f, 0.f};
      const float* hp = H + ch * 132 + quad * 32;
#pragma unroll
      for (int i = 0; i < 8; ++i) {
        const float4 hv = *(const float4*)(hp + 4 * i);
        acc = __builtin_amdgcn_mfma_f32_16x16x4f32(hv.x, creg[4 * i], acc, 0, 0, 0);
        acc = __builtin_amdgcn_mfma_f32_16x16x4f32(hv.y, creg[4 * i + 1], acc, 0, 0, 0);
        acc = __builtin_amdgcn_mfma_f32_16x16x4f32(hv.z, creg[4 * i + 2], acc, 0, 0, 0);
        acc = __builtin_amdgcn_mfma_f32_16x16x4f32(hv.w, creg[4 * i + 3], acc, 0, 0, 0);
      }
#pragma unroll
      for (int r = 0; r < 4; ++r) {
        const int tl = quad * 4 + r;
        float y = acc[r] + dsk * us[tl * 16 + ch];
        const float y3 = y * y * y;
        y = y * sigm(1.5957691216057308f * (y + 0.044715f * y3));
        p.y_pre[(tok0 + s * 16 + tl) * 512 + g * 16 + ch] = f2bf(y);
      }
    }
  }
  if (!FULL) p.E[((size_t)(b * 32 + g) * 64 + c) * 64 + lane] = make_float2(hr, hi);
}

DI unsigned mono(float f) { const unsigned u = __float_as_uint(f); return (u & 0x80000000u) ? ~u : (u | 0x80000000u); }

struct SelPre { bf16x8 a[4]; float4 w[4]; };
DI void select_prefetch(const P& p, int b, int quad4, SelPre& pre) {
  const int t0 = quad4 * 4;
  if (t0 < 256) return;
  const int lane = TIDX() & 63, r = lane & 31, h = lane >> 5;
  const size_t tok0 = (size_t)b * SEQ + t0;
  const bf16_t* qp = p.qidx + (tok0 + (r >> 3)) * 512 + (r & 7) * 64 + h * 8;
#pragma unroll
  for (int s = 0; s < 4; ++s) pre.a[s] = *(const bf16x8*)(qp + s * 16);
#pragma unroll
  for (int q = 0; q < 4; ++q) pre.w[q] = *(const float4*)(p.widx + (tok0 + q) * 8 + h * 4);
}
DI void select_item(const P& p, int b, int quad4, int bid, char* smem, const SelPre& pre) {
  const int t0 = quad4 * 4;
  if (t0 < 256) return;
  const int tid = TIDX(), lane = tid & 63, wave = tid >> 6;
  unsigned* hist = (unsigned*)smem + wave * 256;
  unsigned* candi = (unsigned*)smem + 1024 + wave * 512;
  unsigned* candk = candi + 256;
  unsigned short* sc16 = (unsigned short*)((unsigned*)smem + 3072);
  unsigned* scr = p.scr + (size_t)bid * 4 * 8192;
  const size_t tok0 = (size_t)b * SEQ + t0;
  __syncthreads();
  {
    const int r = lane & 31, h = lane >> 5;
    bf16x8 a[4];
    float4 w[4];
#pragma unroll
    for (int s = 0; s < 4; ++s) { a[s] = pre.a[s]; w[s] = pre.w[s]; }
    const int ntile = (t0 + 4 + 31) >> 5;
    const bf16_t* kbase = p.kidx + ((size_t)b * SEQ) * 64 + h * 8;
    const int nit = (ntile - wave + 3) >> 2;
#pragma unroll 1
    for (int i0 = 0; i0 < nit; i0 += 4) {
      bf16x8 bf[4][4];
#pragma unroll
      for (int u = 0; u < 4; ++u) {
        int kt = wave + 4 * (i0 + u); kt = kt < ntile ? kt : ntile - 1;
        const bf16_t* kp = kbase + (size_t)(kt * 32 + r) * 64;
#pragma unroll
        for (int s = 0; s < 4; ++s) bf[u][s] = *(const bf16x8*)(kp + s * 16);
      }
#pragma unroll
      for (int u = 0; u < 4; ++u) {
        const int key = (wave + 4 * (i0 + u)) * 32 + r;
        f32x16 acc;
#pragma unroll
        for (int i = 0; i < 16; ++i) acc[i] = 0.f;
#pragma unroll
        for (int s = 0; s < 4; ++s) acc = __builtin_amdgcn_mfma_f32_32x32x16_bf16(a[s], bf[u][s], acc, 0, 0, 0);
        float tot[4];
#pragma unroll
        for (int q = 0; q < 4; ++q) {
          float sq = 0.f;
          sq = fmaf(fmaxf(acc[4 * q + 0], 0.f), w[q].x, sq); sq = fmaf(fmaxf(acc[4 * q + 1], 0.f), w[q].y, sq);
          sq = fmaf(fmaxf(acc[4 * q + 2], 0.f), w[q].z, sq); sq = fmaf(fmaxf(acc[4 * q + 3], 0.f), w[q].w, sq);
          tot[q] = sq + __shfl_xor(sq, 32);
        }
        if (i0 + u < nit) {
          const unsigned m0 = mono(h == 0 ? tot[0] : tot[2]), m1 = mono(h == 0 ? tot[1] : tot[3]);
          const int q0 = h * 2;
          sc16[q0 * 8192 + key] = (unsigned short)(m0 >> 16); sc16[(q0 + 1) * 8192 + key] = (unsigned short)(m1 >> 16);
          __builtin_nontemporal_store(m0, scr + q0 * 8192 + key); __builtin_nontemporal_store(m1, scr + (q0 + 1) * 8192 + key);
        }
      }
    }
  }
  __syncthreads();
  {
    const int qi = wave, n = t0 + qi + 1;
    const unsigned short* s = sc16 + qi * 8192;
    const unsigned* s32 = (const unsigned*)s;
    unsigned prefix = 0, pmask = 0, need = 256, eq_total = 0;
#pragma unroll 1
    for (int pass = 0; pass < 2; ++pass) {
      const int shift = 8 - 8 * pass;
#pragma unroll
      for (int k = 0; k < 4; ++k) hist[lane + 64 * k] = 0;
      __builtin_amdgcn_wave_barrier();
      for (int e2 = lane; 2 * e2 < n; e2 += 64) {
        const unsigned wv = s32[e2];
        const unsigned k0 = wv & 0xffffu, k1 = wv >> 16;
        if ((k0 & pmask) == prefix) atomicAdd(&hist[(k0 >> shift) & 255], 1u);
        if (2 * e2 + 1 < n && (k1 & pmask) == prefix) atomicAdd(&hist[(k1 >> shift) & 255], 1u);
      }
      __builtin_amdgcn_wave_barrier();
      const uint4 h4 = *(const uint4*)(hist + 4 * lane);
      const unsigned sum = h4.x + h4.y + h4.z + h4.w;
      unsigned incl = sum;
#pragma unroll
      for (int off = 1; off < 64; off <<= 1) { const unsigned v = __shfl_down(incl, off); if (lane + off < 64) incl += v; }
      unsigned above = incl - sum;
      const bool found = above < need && need <= incl;
      unsigned dig = 0, cnt = 0;
      if (found) {
        if (above + h4.w >= need) { dig = 3; cnt = h4.w; }
        else { above += h4.w;
          if (above + h4.z >= need) { dig = 2; cnt = h4.z; }
          else { above += h4.z;
            if (above + h4.y >= need) { dig = 1; cnt = h4.y; }
            else { above += h4.y; dig = 0; cnt = h4.x; } } }
        dig += 4 * lane;
      }
      const unsigned long long fb = __ballot(found);
      const int fl = fb ? (__ffsll((long long)fb) - 1) : 0;
      const unsigned dsel = __shfl(dig, fl), nneed = __shfl(need - above, fl), ncnt = __shfl(cnt, fl);
      prefix |= dsel << shift; pmask |= 0xffu << shift; need = nneed; eq_total = ncnt;
      __builtin_amdgcn_wave_barrier();
    }
    const unsigned thr = prefix, ngt = 256 - need;
    unsigned short* dst = p.sel + (tok0 + qi) * 256;
    const unsigned long long lm = (1ull << lane) - 1ull;
    unsigned og = 0, oe = 0;
    for (int base = 0; base < n; base += 64) {
      const int e = base + lane;
      const unsigned u = e < n ? (unsigned)s[e] : 0u;
      const bool isg = e < n && u > thr, ise = e < n && u == thr;
      const unsigned long long bg = __ballot(isg), be = __ballot(ise);
      if (isg) { const unsigned pos = og + __popcll(bg & lm); if (pos < 256u) dst[pos] = (unsigned short)e; }
      if (ise) { const unsigned rr = oe + __popcll(be & lm); if (rr < 256u) candi[rr] = (unsigned)e; }
      og += __popcll(bg); oe += __popcll(be);
    }
    __builtin_amdgcn_wave_barrier();
    const unsigned c = eq_total < 256u ? eq_total : 256u;
    if (eq_total == need) {
      for (unsigned i = lane; i < c; i += 64) if (ngt + i < 256u) dst[ngt + i] = (unsigned short)candi[i];
    } else {
      for (unsigned i = lane; i < c; i += 64) candk[i] = __hip_atomic_load(scr + qi * 8192 + candi[i], __ATOMIC_RELAXED, __HIP_MEMORY_SCOPE_AGENT);
      __builtin_amdgcn_wave_barrier();
      for (unsigned i = lane; i < c; i += 64) {
        const unsigned ki = candk[i];
        unsigned rank = 0;
        for (unsigned j2 = 0; j2 < c; ++j2) { const unsigned kj = candk[j2]; rank += (kj > ki || (kj == ki && j2 < i)) ? 1u : 0u; }
        if (rank < need && ngt + rank < 256u) dst[ngt + rank] = (unsigned short)candi[i];
      }
    }
  }
  __syncthreads();
}

struct AttnPre { uint2 sv; u32x4 tq[4]; };
DI void attn_prefetch(const P& p, int b, int kvh, int quad4, AttnPre& pre) {
  const int tid = TIDX(), lane = tid & 63, wave = tid >> 6;
  const int t = quad4 * 4 + wave;
  const size_t tok = (size_t)b * SEQ + t;
  const int r = lane & 15, quad = lane >> 4;
  pre.sv = make_uint2(0u, 0u);
  if (t >= 256) { const u32x2 t2 = __builtin_nontemporal_load((const u32x2*)(p.sel + tok * 256 + lane * 4)); pre.sv = make_uint2(t2[0], t2[1]); }
  const bf16_t* qp = p.q + tok * 1024 + (kvh * 4 + (r & 3)) * 128 + quad * 16;
#pragma unroll
  for (int s = 0; s < 4; ++s) pre.tq[s] = __builtin_nontemporal_load((const u32x4*)(qp + (s >> 1) * 64 + (s & 1) * 8));
}
DI void attn_item(const P& p, int b, int kvh, int quad4, char* smem, const AttnPre& pre) {
  const int tid = TIDX(), lane = tid & 63, wave = tid >> 6;
  const int t = quad4 * 4 + wave;
  const size_t tok = (size_t)b * SEQ + t;
  float* L = (float*)smem + wave * (1024 + 256);
  int* idx = (int*)(L + 1024);
  const int cnt = t < 256 ? t + 1 : 256;
  __builtin_amdgcn_wave_barrier();
  if (t < 256) {
#pragma unroll
    for (int j = 0; j < 4; ++j) { const int n = lane + 64 * j; idx[n] = n < cnt ? n : 0; }
  } else {
    const uint2 sv = pre.sv;
    idx[lane * 4 + 0] = sv.x & 0xffff; idx[lane * 4 + 1] = sv.x >> 16; idx[lane * 4 + 2] = sv.y & 0xffff; idx[lane * 4 + 3] = sv.y >> 16;
  }
  const int r = lane & 15, quad = lane >> 4;
  long qa8[4];
  {
    const bf16_t* qp = p.q + tok * 1024 + (kvh * 4 + (r & 3)) * 128 + quad * 16;
#pragma unroll
    for (int s = 0; s < 4; ++s) {
      const u32x4 tq = pre.tq[s];
      float f[8];
#pragma unroll
      for (int e = 0; e < 4; ++e) { f[2 * e] = __uint_as_float(tq[e] << 16); f[2 * e + 1] = __uint_as_float(tq[e] & 0xffff0000u); }
      const uint2 pk = pack8_fp8(f);
      long v = (long)(((unsigned long long)pk.y << 32) | (unsigned long long)pk.x);
      if (r >= 4) v = 0;
      qa8[s] = v;
    }
  }
  __builtin_amdgcn_wave_barrier();
  const unsigned char* kb = p.k8 + ((size_t)b * SEQ) * 256 + kvh * 128 + quad * 16;
  int myidx[16];
#pragma unroll
  for (int kt = 0; kt < 16; ++kt) myidx[kt] = idx[kt * 16 + r];
#pragma unroll
  for (int kt0 = 0; kt0 < 16; kt0 += 8) {
    u32x4 kraw[8][2];
#pragma unroll
    for (int u = 0; u < 8; ++u) {
      const unsigned char* kp = kb + (size_t)myidx[kt0 + u] * 256;
      kraw[u][0] = *(const u32x4*)kp; kraw[u][1] = *(const u32x4*)(kp + 64);
    }
#pragma unroll
    for (int u = 0; u < 8; ++u) {
      const int n = (kt0 + u) * 16 + r;
      f32x4 acc = {0.f, 0.f, 0.f, 0.f};
#pragma unroll
      for (int S = 0; S < 2; ++S) {
        const long k0 = (long)(((unsigned long long)kraw[u][S][1] << 32) | (unsigned long long)kraw[u][S][0]);
        const long k1 = (long)(((unsigned long long)kraw[u][S][3] << 32) | (unsigned long long)kraw[u][S][2]);
        acc = __builtin_amdgcn_mfma_f32_16x16x32_fp8_fp8(qa8[2 * S], k0, acc, 0, 0, 0);
        acc = __builtin_amdgcn_mfma_f32_16x16x32_fp8_fp8(qa8[2 * S + 1], k1, acc, 0, 0, 0);
      }
      if (quad == 0) {
        const bool ok = n < cnt;
#pragma unroll
        for (int h = 0; h < 4; ++h) L[h * 256 + n] = ok ? acc[h] * ATT_SCALE : -INFINITY;
      }
    }
  }
  __builtin_amdgcn_wave_barrier();
  float pr[4][4];
#pragma unroll
  for (int h = 0; h < 4; ++h) {
    float m = -INFINITY;
#pragma unroll
    for (int j = 0; j < 4; ++j) { pr[h][j] = L[h * 256 + lane + 64 * j]; m = fmaxf(m, pr[h][j]); }
#pragma unroll
    for (int off = 32; off >= 1; off >>= 1) m = fmaxf(m, __shfl_xor(m, off));
    float sum = 0.f;
#pragma unroll
    for (int j = 0; j < 4; ++j) { pr[h][j] = __expf(pr[h][j] - m); sum += pr[h][j]; }
#pragma unroll
    for (int off = 32; off >= 1; off >>= 1) sum += __shfl_xor(sum, off);
    const float inv = 1.f / sum;
#pragma unroll
    for (int j = 0; j < 4; ++j) pr[h][j] *= inv;
  }
  __builtin_amdgcn_wave_barrier();
#pragma unroll
  for (int j = 0; j < 4; ++j) *(float4*)(L + (lane + 64 * j) * 4) = make_float4(pr[0][j], pr[1][j], pr[2][j], pr[3][j]);
  __builtin_amdgcn_wave_barrier();
  float o[4][8];
#pragma unroll
  for (int h = 0; h < 4; ++h)
#pragma unroll
    for (int e = 0; e < 8; ++e) o[h][e] = 0.f;
  const unsigned char* vb = p.v8 + ((size_t)b * SEQ) * 256 + kvh * 128 + r * 8;
#pragma unroll 1
  for (int n0 = 0; n0 < 256; n0 += 64) {
    uint2 vv[16];
#pragma unroll
    for (int u = 0; u < 16; ++u) vv[u] = *(const uint2*)(vb + (size_t)idx[n0 + 4 * u + quad] * 256);
#pragma unroll
    for (int u = 0; u < 16; ++u) {
      const float4 p4 = *(const float4*)(L + (n0 + 4 * u + quad) * 4);
      const f32x2_t c0 = __builtin_amdgcn_cvt_pk_f32_fp8((int)vv[u].x, false), c1 = __builtin_amdgcn_cvt_pk_f32_fp8((int)vv[u].x, true);
      const f32x2_t c2 = __builtin_amdgcn_cvt_pk_f32_fp8((int)vv[u].y, false), c3 = __builtin_amdgcn_cvt_pk_f32_fp8((int)vv[u].y, true);
      const float vf[8] = {c0.x, c0.y, c1.x, c1.y, c2.x, c2.y, c3.x, c3.y};
#pragma unroll
      for (int e = 0; e < 8; ++e) {
        o[0][e] = fmaf(p4.x, vf[e], o[0][e]); o[1][e] = fmaf(p4.y, vf[e], o[1][e]);
        o[2][e] = fmaf(p4.z, vf[e], o[2][e]); o[3][e] = fmaf(p4.w, vf[e], o[3][e]);
      }
    }
  }
#pragma unroll
  for (int h = 0; h < 4; ++h)
#pragma unroll
    for (int e = 0; e < 8; ++e) { float v = o[h][e]; v += __shfl_xor(v, 16); v += __shfl_xor(v, 32); o[h][e] = v; }
  if (quad == 0) {
#pragma unroll
    for (int h = 0; h < 4; ++h) *(uint4*)(p.q + tok * 1024 + (kvh * 4 + h) * 128 + r * 8) = pack8(o[h]);
  }
}

template <int GRP>
DI void ln_items(float* X, const float* gam, const float* bet, bf16_t* u2, const float* sc, const float* sh, int item0) {
  const int tid = TIDX(), lane = tid & 63, wave = tid >> 6;
  f32x4 v[GRP][4];
#pragma unroll
  for (int g = 0; g < GRP; ++g) {
    const size_t tok = (size_t)(item0 + g) * 4 + wave;
#pragma unroll
    for (int j = 0; j < 4; ++j) v[g][j] = *(const f32x4*)(X + tok * 1024 + j * 256 + lane * 4);
  }
#pragma unroll
  for (int g = 0; g < GRP; ++g) {
    const size_t tok = (size_t)(item0 + g) * 4 + wave;
    const int b = (int)(tok >> 13);
    float s = 0.f;
#pragma unroll
    for (int j = 0; j < 4; ++j) s += v[g][j][0] + v[g][j][1] + v[g][j][2] + v[g][j][3];
#pragma unroll
    for (int off = 32; off >= 1; off >>= 1) s += __shfl_xor(s, off);
    const float mu = s * (1.f / 1024.f);
    float q = 0.f;
#pragma unroll
    for (int j = 0; j < 4; ++j)
#pragma unroll
      for (int e = 0; e < 4; ++e) { const float d = v[g][j][e] - mu; q += d * d; }
#pragma unroll
    for (int off = 32; off >= 1; off >>= 1) q += __shfl_xor(q, off);
    const float rstd = rsqrtf(q * (1.f / 1024.f) + 1e-5f);
#pragma unroll
    for (int j = 0; j < 4; ++j) {
      const int col = j * 256 + lane * 4;
      const f32x4 gg = *(const f32x4*)(gam + col), be = *(const f32x4*)(bet + col);
      f32x4 y;
#pragma unroll
      for (int e = 0; e < 4; ++e) y[e] = (v[g][j][e] - mu) * rstd * gg[e] + be[e];
      *(f32x4*)(X + tok * 1024 + col) = y;
      if (u2) {
        const f32x4 s4 = *(const f32x4*)(sc + b * 6144 + col), h4 = *(const f32x4*)(sh + b * 6144 + col);
        uint2 o;
        o.x = pack2(y[0] * (1.f + s4[0]) + h4[0], y[1] * (1.f + s4[1]) + h4[1]);
        o.y = pack2(y[2] * (1.f + s4[2]) + h4[2], y[3] * (1.f + s4[3]) + h4[3]);
        *(uint2*)(u2 + tok * 1024 + col) = o;
      }
    }
  }
}

enum { PH_PRO = 0, PH_U1, PH_INPROJ, PH_SEL, PH_SSMA, PH_ATTN, PH_SSMB, PH_CHA, PH_CHB, PH_COUNT };

DI void run_phase(const P& p, int ph, int l, int bid, int nblk, char* smem) {
  const float* modl = p.mod + (size_t)l * 8 * 6144;
  const bf16_t* wl = p.wT + (size_t)l * WO_LAYER;
  const float* xin = (l == 0) ? p.x : p.out;
  switch (ph) {
    case PH_PRO:
      for (int it = bid; it < N_PRO; it += nblk) prologue_item(p, it, smem);
      break;
    case PH_U1:
      for (int it = bid; it < NTOK / 2; it += nblk) {
        const size_t e0 = (size_t)it * 2048 + TIDX() * 8;
        const int b = (int)(e0 >> 23), col = (int)(e0 & 1023);
        const f32x4 x0 = __builtin_nontemporal_load((const f32x4*)(xin + e0)), x1 = __builtin_nontemporal_load((const f32x4*)(xin + e0 + 4));
        const float4 s0 = *(const float4*)(modl + b * 6144 + 1024 + col), s1 = *(const float4*)(modl + b * 6144 + 1024 + col + 4);
        const float4 h0 = *(const float4*)(modl + b * 6144 + col), h1 = *(const float4*)(modl + b * 6144 + col + 4);
        uint4 r;
        r.x = pack2(x0.x * (1.f + s0.x) + h0.x, x0.y * (1.f + s0.y) + h0.y);
        r.y = pack2(x0.z * (1.f + s0.z) + h0.z, x0.w * (1.f + s0.w) + h0.w);
        r.z = pack2(x1.x * (1.f + s1.x) + h1.x, x1.y * (1.f + s1.y) + h1.y);
        r.w = pack2(x1.z * (1.f + s1.z) + h1.z, x1.w * (1.f + s1.w) + h1.w);
        *(uint4*)((bf16_t*)p.XA + e0) = r;
      }
      break;
    case PH_INPROJ: {
      ALoadBf16 al{(const bf16_t*)p.XA, 1024};
      EpiInproj epi{p};
      if ((nblk & 7) == 0) {
        const int x = bid & 7, j = bid >> 3, nj = nblk >> 3;
        for (int i = j; i < 64 * 19; i += nj) gemm_wide(al, wl + WO_IN, 1024, (x + 8 * (i / 19)) * 128, (i % 19) * 256, (i % 19) == 18 ? 1 : 2, smem, epi);
      } else {
        for (int it = bid; it < 512 * 19; it += nblk) gemm_wide(al, wl + WO_IN, 1024, (it / 19) * 128, (it % 19) * 256, (it % 19) == 18 ? 1 : 2, smem, epi);
      }
    } break;
    case PH_SEL:
      if ((nblk & 7) == 0) {
        const int b = bid & 7, j = bid >> 3, nj = nblk >> 3;
        SelPre sa, sb;
        if (j < 2048) select_prefetch(p, b, 2047 - j, sa);
        for (int i = j; i < 2048; i += nj) {
          const int inext = i + nj;
          if (inext < 2048) select_prefetch(p, b, 2047 - inext, sb);
          select_item(p, b, 2047 - i, bid, smem, sa);
          sa = sb;
        }
      } else {
        for (int it = bid; it < 16384; it += nblk) { SelPre sa; select_prefetch(p, it >> 11, 2047 - (it & 2047), sa); select_item(p, it >> 11, 2047 - (it & 2047), bid, smem, sa); }
      }
      break;
    case PH_SSMA:
      for (int it = bid; it < 4096; it += nblk) ssm_item<false>(p, l, it, smem);
      break;
    case PH_ATTN:
      if ((nblk & 7) == 0) {
        const int b = bid & 7, j = bid >> 3, nj = nblk >> 3;
        AttnPre pa, pb;
        if (j < 4096) attn_prefetch(p, b, j >> 11, j & 2047, pa);
        for (int i = j; i < 4096; i += nj) {
          const int inext = i + nj;
          if (inext < 4096) attn_prefetch(p, b, inext >> 11, inext & 2047, pb);
          attn_item(p, b, i >> 11, i & 2047, smem, pa);
          pa = pb;
        }
      } else {
        for (int it = bid; it < 32768; it += nblk) { AttnPre pa; attn_prefetch(p, it >> 12, (it >> 11) & 1, it & 2047, pa); attn_item(p, it >> 12, (it >> 11) & 1, it & 2047, smem, pa); }
      }
      break;
    case PH_SSMB:
      for (int it = bid; it < 4096; it += nblk) ssm_item<true>(p, l, it, smem);
      break;
    case PH_CHA: {
      ALoadBf16 aglu{p.y_pre, 512}, a1{p.y_ssm, 512}, a2{p.q, 1024}, aout{p.sg_s, 1024};
      EpiGlu eglu{p, p.b_glu + l * 512};
      EpiMerge1 e1{p}; EpiMerge2 e2{p};
      EpiResid eres{xin, modl + 2048, p.XA};
#pragma unroll 1
      for (int m = bid; m < 512; m += nblk) {
        const int m0 = m * 128;
#pragma unroll 1
        for (int n = 0; n < 2; ++n) gemm_wide(aglu, wl + WO_GLU, 512, m0, n * 256, 2, smem, eglu);
        __syncthreads();
#pragma unroll 1
        for (int n = 0; n < 4; ++n) {
          gemm_wide(a1, wl + WO_PSSM, 512, m0, n * 256, 2, smem, e1);
          gemm_wide(a2, wl + WO_PATTN, 1024, m0, n * 256, 2, smem, e2);
        }
        __syncthreads();
#pragma unroll 1
        for (int n = 0; n < 4; ++n) gemm_wide(aout, wl + WO_OUT, 1024, m0, n * 256, 2, smem, eres);
        __syncthreads();
#pragma unroll 1
        for (int i = 0; i < 32; i += 4) ln_items<4>(p.XA, p.ln1_g + l * 1024, p.ln1_b + l * 1024, p.u2, modl + 4096, modl + 3072, m * 32 + i);
        __syncthreads();
      }
    } break;
    case PH_CHB: {
      ALoadBf16 agu{p.u2, 1024}, adn{p.act, DFF};
      EpiGateUp egu{p};
      EpiResid eres{p.XA, modl + 5120, p.out};
#pragma unroll 1
      for (int m = bid; m < 512; m += nblk) {
        const int m0 = m * 128;
#pragma unroll 1
        for (int n = 0; n < 22; ++n) gemm_wide(agu, wl + WO_GU, 1024, m0, ((n + (m & 3)) % 22) * 256, 2, smem, egu);
        __syncthreads();
#pragma unroll 1
        for (int n = 0; n < 4; ++n) gemm_wide(adn, wl + WO_DOWN, DFF, m0, n * 256, 2, smem, eres);
        __syncthreads();
#pragma unroll 1
        for (int i = 0; i < 32; i += 4) ln_items<4>(p.out, p.ln2_g + l * 1024, p.ln2_b + l * 1024, nullptr, nullptr, nullptr, m * 32 + i);
        __syncthreads();
      }
    } break;
  }
}

template <int PH> __global__ void __launch_bounds__(256, 2) k_phase(P p, int l) {
  extern __shared__ __attribute__((aligned(16))) char smem[];
  run_phase(p, PH, l, blockIdx.x, gridDim.x, smem);
}
template <int PH> static void launch_phase(const P& p, int l, int G, hipStream_t stream) {
  static bool attr = false;
  if (!attr) { attr = true; (void)hipFuncSetAttribute((const void*)k_phase<PH>, hipFuncAttributeMaxDynamicSharedMemorySize, LDS_BYTES); }
  hipLaunchKernelGGL((k_phase<PH>), dim3(G), dim3(256), LDS_BYTES, stream, p, l);
}

#if MEGA
__global__ void __launch_bounds__(256, 2) k_mega(P p) {
  extern __shared__ __attribute__((aligned(16))) char smem[];
  cg::grid_group grid = cg::this_grid();
  run_phase(p, PH_PRO, 0, blockIdx.x, gridDim.x, smem);
  grid.sync();
#pragma unroll 1
  for (int l = 0; l < 2; ++l) {
#pragma unroll 1
    for (int ph = PH_U1; ph < PH_COUNT; ++ph) {
      run_phase(p, ph, l, blockIdx.x, gridDim.x, smem);
      if (!(l == 1 && ph == PH_CHB)) grid.sync();
    }
  }
}
#endif


extern "C" void kernel_launch(void* const* d_in, const int* in_sizes, int n_in, void* d_out, int out_size, void* d_ws, size_t ws_size, hipStream_t stream) {
  constexpr size_t MiB = 1ull << 20;
  size_t off = 0;
  auto take = [&](size_t bytes) { size_t o = off; off += (bytes + 255) & ~(size_t)255; return o; };
  const size_t o_wT = take(2 * WO_LAYER * 2);
  const size_t o_rope128 = take(8192 * 64 * 8), o_rope64 = take(8192 * 32 * 8);
  const size_t o_ssmA = take(2 * 32 * 64 * 16), o_ssmB = take(2 * 32 * 64 * 16 * 8), o_mod = take(2 * 8 * 6144 * 4), o_E = take((size_t)8 * 32 * 64 * 64 * 8);
  const size_t o_XA = take((size_t)NTOK * 1024 * 4);
  const size_t o_sel = take((size_t)NTOK * 256 * 2);
  const size_t o_P = off;
  const size_t o_ussm = take((size_t)NTOK * 512 * 2), o_q = take((size_t)NTOK * 1024 * 2), o_k = take((size_t)NTOK * 256 * 2), o_v = take((size_t)NTOK * 256 * 2);
  const size_t o_qidx = take((size_t)NTOK * 512 * 2), o_kidx = take((size_t)NTOK * 64 * 2), o_widx = take((size_t)NTOK * 8 * 4);
  const size_t o_sgs = take((size_t)NTOK * 1024 * 2), o_sga = take((size_t)NTOK * 1024 * 2);
  const size_t o_scr = take((size_t)512 * 4 * 8192 * 4);
  const size_t total = off;
  static int state = 0, grid_blocks = 0;
  if (state == 0) {
    state = 1;
    if (n_in != 24 || out_size != NTOK * 1024 || ws_size < total) {
      fprintf(stderr, "kernel_launch: unexpected sizes n_in %d out %d ws %zu (need %zu)\n", n_in, out_size, ws_size, total);
      state = -1;
    } else {
      int dev = 0, cus = 0, per_cu = 0;
      hipGetDevice(&dev);
      hipDeviceGetAttribute(&cus, hipDeviceAttributeMultiprocessorCount, dev);
#if MEGA
      hipFuncSetAttribute((const void*)k_mega, hipFuncAttributeMaxDynamicSharedMemorySize, LDS_BYTES);
      hipOccupancyMaxActiveBlocksPerMultiprocessor(&per_cu, (const void*)k_mega, 256, LDS_BYTES);
#endif
      if (per_cu < 1) per_cu = 1;
      if (per_cu > 2) per_cu = 2;
      grid_blocks = cus * per_cu;
      if (grid_blocks > 512) grid_blocks = 512;
      (void)hipGetLastError();
    }
  }
  if (state < 0) return;
  (void)MiB; (void)in_sizes;
  char* ws = (char*)d_ws;
  P p{};
  const float** f = (const float**)&p;
  for (int i = 0; i < 24; ++i) f[i] = (const float*)d_in[i];
  p.out = (float*)d_out;
  p.wT = (bf16_t*)(ws + o_wT);
  p.rope128 = (float2*)(ws + o_rope128); p.rope64 = (float2*)(ws + o_rope64);
  p.ssmA = (float4*)(ws + o_ssmA); p.ssmB = (float2*)(ws + o_ssmB); p.mod = (float*)(ws + o_mod); p.E = (float2*)(ws + o_E);
  p.XA = (float*)(ws + o_XA);
  p.sel = (unsigned short*)(ws + o_sel);
  p.scr = (unsigned*)(ws + o_scr);
  p.u_ssm = (bf16_t*)(ws + o_ussm); p.q = (bf16_t*)(ws + o_q); p.k = (bf16_t*)(ws + o_k); p.v = (bf16_t*)(ws + o_v);
  p.k8 = (unsigned char*)(ws + o_k); p.v8 = (unsigned char*)(ws + o_v);
  p.qidx = (bf16_t*)(ws + o_qidx); p.kidx = (bf16_t*)(ws + o_kidx); p.widx = (float*)(ws + o_widx);
  p.sg_s = (bf16_t*)(ws + o_sgs); p.sg_a = (bf16_t*)(ws + o_sga);
  p.y_pre = p.qidx;
  p.y_ssm = p.u_ssm;
  p.act = (bf16_t*)(ws + o_sel);
  p.u2 = p.sg_a;
#if MEGA
  void* args[] = {&p};
  hipError_t e = hipLaunchCooperativeKernel((const void*)k_mega, dim3(grid_blocks), dim3(256), args, LDS_BYTES, stream);
  if (e != hipSuccess) fprintf(stderr, "cooperative launch failed: %s (grid %d)\n", hipGetErrorString(e), grid_blocks);
#else
  const int G = 2048;
  launch_phase<PH_PRO>(p, 0, G, stream);
  for (int l = 0; l < 2; ++l) {
    launch_phase<PH_U1>(p, l, G, stream); launch_phase<PH_INPROJ>(p, l, G, stream); launch_phase<PH_SEL>(p, l, G, stream);
    launch_phase<PH_SSMA>(p, l, G, stream); launch_phase<PH_ATTN>(p, l, G, stream); launch_phase<PH_SSMB>(p, l, G, stream);
    launch_phase<PH_CHA>(p, l, G, stream); launch_phase<PH_CHB>(p, l, G, stream);
  }
#endif
}
```
